# Optimizing an MI355X kernel written in HIP

```python
import math
import jax, jax.numpy as jnp
from jax import lax
import numpy as np

D_MODEL = 4096
BATCH = 4
SEQ = 2048
DEPTH = 1

D_MIX = D_MODEL
POOL_WINDOWS = (2, 4, 8, 16)
N_POOL_GROUPS = len(POOL_WINDOWS)
D_POOL = D_MIX // 4
POOL_GROUP = D_POOL // N_POOL_GROUPS
D_ATTN = D_MIX - D_POOL
HEAD_DIM = 128
N_HEADS = D_ATTN // (2 * HEAD_DIM)
D_QK = N_HEADS * 2 * HEAD_DIM
D_V = N_HEADS * 2 * HEAD_DIM
D_IN = D_POOL + 2 * D_QK + D_V
Q_BLOCK = 128
D_FF = ((8 * D_MODEL // 3 + 255) // 256) * 256
N_SUB = 3
N_MOD = 3
NORM_EPS = 1e-6

kernel_name = "hybrid_pool_diffattn_macaron_layer"


def rms_norm(x, g, eps=NORM_EPS):
    xf = x.astype(jnp.float32)
    y = xf * lax.rsqrt(jnp.mean(xf * xf, axis=-1, keepdims=True) + eps)
    return (y * g.astype(jnp.float32)).astype(x.dtype)


def modulate(h, shift, scale):
    return h * (1.0 + scale[:, None, :]) + shift[:, None, :]


def swiglu(h, w1, w3, w2):
    return (jax.nn.silu(h @ w1) * (h @ w3)) @ w2


def pool_mixer(u, w_pool, pool_scale):
    b, s, _ = u.shape
    ug = u.reshape(b, s, N_POOL_GROUPS, POOL_GROUP).astype(jnp.float32)
    cs = jnp.pad(jnp.cumsum(ug, axis=1), ((0, 0), (1, 0), (0, 0), (0, 0)))
    win = jnp.array(POOL_WINDOWS, dtype=jnp.int32)
    t = jnp.arange(s, dtype=jnp.int32)[:, None]
    lo = jnp.maximum(t + 1 - win[None, :], 0)
    grp = jnp.arange(N_POOL_GROUPS, dtype=jnp.int32)[None, :]
    window_sum = cs[:, 1:] - cs[:, lo, grp]
    count = jnp.minimum(t + 1, win[None, :]).astype(jnp.float32)
    y = window_sum / count[None, :, :, None] - ug
    y = jnp.einsum('bsgc,gcd->bsgd', y.astype(u.dtype), w_pool)
    return y.reshape(b, s, D_POOL) * pool_scale


def diff_attention(q, k, v, lam, subln_g, lambda_init):
    b, s = q.shape[:2]
    n_blk = s // Q_BLOCK
    qb = (q * (HEAD_DIM ** -0.5)).reshape(b, n_blk, Q_BLOCK, N_HEADS, 2, HEAD_DIM)
    qb = qb.transpose(1, 0, 2, 3, 4, 5)
    key_pos = jnp.arange(s, dtype=jnp.int32)
    starts = jnp.arange(n_blk, dtype=jnp.int32) * Q_BLOCK

    def block(args):
        q_blk, start = args
        scores = jnp.einsum('bqhmd,bkhmd->bhmqk', q_blk, k).astype(jnp.float32)
        q_pos = start + jnp.arange(Q_BLOCK, dtype=jnp.int32)
        causal = key_pos[None, :] <= q_pos[:, None]
        scores = jnp.where(causal, scores, -jnp.inf)
        p = jax.nn.softmax(scores, axis=-1)
        a = p[:, :, 0] - lam * p[:, :, 1]
        return jnp.einsum('bhqk,bkhe->bqhe', a.astype(v.dtype), v)

    o = lax.map(block, (qb, starts))
    o = o.transpose(1, 0, 2, 3, 4).reshape(b, s, N_HEADS, 2 * HEAD_DIM)
    o = rms_norm(o, subln_g) * (1.0 - lambda_init)
    return o.reshape(b, s, N_HEADS * 2 * HEAD_DIM)


def setup_inputs(seed: int = 0) -> dict:
    key = jax.random.key(seed)
    ks = jax.random.split(key, 24)
    f32 = jnp.float32
    nrm = lambda k, shape, s: jax.random.normal(k, shape, f32) * s
    L = DEPTH
    return {
        "x": nrm(ks[0], (BATCH, SEQ, D_MODEL), 1.0),
        "c": nrm(ks[1], (BATCH, D_MODEL), 1.0),
        "w_ada": nrm(ks[2], (L, D_MODEL, N_SUB * N_MOD * D_MODEL), D_MODEL ** -0.5),
        "b_ada": nrm(ks[3], (L, N_SUB * N_MOD * D_MODEL), 0.01),
        "pre_norm_g": 1.0 + nrm(ks[4], (L, N_SUB, D_MODEL), 0.02),
        "post_norm_g": 1.0 + nrm(ks[5], (L, N_SUB, D_MODEL), 0.02),
        "ffn1_w1": nrm(ks[6], (L, D_MODEL, D_FF), D_MODEL ** -0.5),
        "ffn1_w3": nrm(ks[7], (L, D_MODEL, D_FF), D_MODEL ** -0.5),
        "ffn1_w2": nrm(ks[8], (L, D_FF, D_MODEL), D_FF ** -0.5),
        "w_in": nrm(ks[9], (L, D_MODEL, D_IN), D_MODEL ** -0.5),
        "w_pool": nrm(ks[10], (L, N_POOL_GROUPS, POOL_GROUP, POOL_GROUP), POOL_GROUP ** -0.5),
        "pool_scale": 1.0 + nrm(ks[11], (L, D_POOL), 0.1),
        "lambda_q1": nrm(ks[12], (L, HEAD_DIM), 0.1),
        "lambda_k1": nrm(ks[13], (L, HEAD_DIM), 0.1),
        "lambda_q2": nrm(ks[14], (L, HEAD_DIM), 0.1),
        "lambda_k2": nrm(ks[15], (L, HEAD_DIM), 0.1),
        "subln_g": 1.0 + nrm(ks[16], (L, 2 * HEAD_DIM), 0.02),
        "w_out": nrm(ks[17], (L, D_MIX, D_MODEL), D_MIX ** -0.5),
        "ffn2_w1": nrm(ks[18], (L, D_MODEL, D_FF), D_MODEL ** -0.5),
        "ffn2_w3": nrm(ks[19], (L, D_MODEL, D_FF), D_MODEL ** -0.5),
        "ffn2_w2": nrm(ks[20], (L, D_FF, D_MODEL), D_FF ** -0.5),
    }


def reference(x, c, w_ada, b_ada, pre_norm_g, post_norm_g, ffn1_w1, ffn1_w3, ffn1_w2,
              w_in, w_pool, pool_scale, lambda_q1, lambda_k1, lambda_q2, lambda_k2,
              subln_g, w_out, ffn2_w1, ffn2_w3, ffn2_w2):
    b, s, _ = x.shape
    for l in range(DEPTH):
        lambda_init = 0.8 - 0.6 * math.exp(-0.3 * l)
        mod = (jax.nn.silu(c) @ w_ada[l] + b_ada[l]).reshape(b, N_SUB, N_MOD, D_MODEL)
        shift, scale, gate = mod[:, :, 0], mod[:, :, 1], mod[:, :, 2]

        h = modulate(rms_norm(x, pre_norm_g[l, 0]), shift[:, 0], scale[:, 0])
        f = rms_norm(swiglu(h, ffn1_w1[l], ffn1_w3[l], ffn1_w2[l]), post_norm_g[l, 0])
        x = x + 0.5 * gate[:, 0, None, :] * f

        h = modulate(rms_norm(x, pre_norm_g[l, 1]), shift[:, 1], scale[:, 1])
        proj = h @ w_in[l]
        u = proj[..., :D_POOL]
        q = proj[..., D_POOL:D_POOL + D_QK].reshape(b, s, N_HEADS, 2, HEAD_DIM)
        k = proj[..., D_POOL + D_QK:D_POOL + 2 * D_QK].reshape(b, s, N_HEADS, 2, HEAD_DIM)
        v = proj[..., D_POOL + 2 * D_QK:].reshape(b, s, N_HEADS, 2 * HEAD_DIM)
        lam = (jnp.exp(jnp.sum(lambda_q1[l].astype(jnp.float32) * lambda_k1[l].astype(jnp.float32)))
               - jnp.exp(jnp.sum(lambda_q2[l].astype(jnp.float32) * lambda_k2[l].astype(jnp.float32)))
               + lambda_init)
        y_pool = pool_mixer(u, w_pool[l], pool_scale[l])
        y_attn = diff_attention(q, k, v, lam, subln_g[l], lambda_init)
        mixed = jnp.concatenate([y_pool, y_attn.astype(y_pool.dtype)], axis=-1) @ w_out[l]
        x = x + gate[:, 1, None, :] * rms_norm(mixed, post_norm_g[l, 1])

        h = modulate(rms_norm(x, pre_norm_g[l, 2]), shift[:, 2], scale[:, 2])
        f = rms_norm(swiglu(h, ffn2_w1[l], ffn2_w3[l], ffn2_w2[l]), post_norm_g[l, 2])
        x = x + 0.5 * gate[:, 2, None, :] * f
    return x
```

```cpp
#include <hip/hip_runtime.h>
#include <hip/hip_bf16.h>
#include <cstdio>
#include <cstdint>
#include <cmath>
namespace pg8 {
#define PG8_LAS __attribute__((address_space(3)))
typedef unsigned short bf16_t;
typedef short bf16x8 __attribute__((ext_vector_type(8)));
typedef float f32x4 __attribute__((ext_vector_type(4)));
typedef unsigned u32x4 __attribute__((ext_vector_type(4)));
constexpr int BM = 256, BK = 64, HALF = 128, HTB = HALF * BK * 2  , STAGE_BYTES = 8 * HTB, NXCD = 8, WGM = 8;

__host__ __device__ __forceinline__ int lds_byte(int r, int c) { const int st = (r >> 4) * 2 + (c >> 5), rr = r & 15, cc = c & 31, ob = rr * 64 + cc * 2; return st * 1024 + (ob ^ (((ob >> 9) & 1) << 5)); }
__host__ __device__ __forceinline__ void stage_rc(int b, int& R, int& C) { const int st = b / 1024, sb = b % 1024, swz = sb ^ (((sb >> 9) & 1) << 5); R = (st >> 1) * 16 + swz / 64; C = (st & 1) * 32 + (swz % 64) / 2; }
__host__ __device__ __forceinline__ int perm32(int rho) { const int n = rho >> 4, i = rho & 15; return 8 * (i >> 2) + 4 * n + (i & 3); }

struct Unit { int pm, pn; };
struct Gemm { const bf16_t* A; const bf16_t* Bt; int M, N, K; };

struct StaticOrder {
    int nM, nN, nwg, G, c;
    __host__ __device__ void init(int M, int N, int G_, int c_) { nM = M / BM; nN = N / BM; nwg = nM * nN; G = G_; c = c_; }
    __host__ __device__ bool next(int i, Unit& u) const {
        const long L = (long)i * G + c; if (L >= nwg) return false;
        int wgid = (int)L; { const int q = nwg / NXCD, r = nwg % NXCD, xcd = wgid % NXCD, off = wgid / NXCD; wgid = (xcd < r ? xcd * (q + 1) : r * (q + 1) + (xcd - r) * q) + off; }
        const int nig = WGM * nN, gid = wgid / nig, fm = gid * WGM, gsz = (nM - fm) < WGM ? (nM - fm) : WGM;
        u.pm = fm + ((wgid % nig) % gsz); u.pn = (wgid % nig) / gsz; return true;
    }
    __device__ __forceinline__ void a_ready(const Unit&) const {}
    __device__ __forceinline__ void done(const Unit&) const {}
};

__device__ __forceinline__ unsigned cvt_pk_bf16(float lo, float hi) { unsigned r; asm volatile("v_cvt_pk_bf16_f32 %0, %1, %2" : "=v"(r) : "v"(lo), "v"(hi)); return r; }
typedef float f32x2 __attribute__((ext_vector_type(2)));

struct EpiF32 {
    static constexpr bool PERM = false, AFTER_DRAIN = false;
    float* C; int ldc;
    __device__ __forceinline__ void operator()(const f32x4 (&acc)[2][2][4][2], const Unit& u, int wr, int wc, int fr, int fq) const {
        const int row0 = u.pm * BM + wr * 64 + fr, col0 = u.pn * BM + wc * 32 + 4 * fq;
#pragma unroll
        for (int ai = 0; ai < 2; ++ai)
#pragma unroll
            for (int m = 0; m < 4; ++m) { float* rowp = C + (size_t)(row0 + ai * HALF + m * 16) * ldc + col0;
#pragma unroll
                for (int bj = 0; bj < 2; ++bj)
#pragma unroll
                    for (int n = 0; n < 2; ++n) *(f32x4*)(rowp + bj * HALF + n * 16) = acc[ai][bj][m][n]; }
    }
};
struct EpiSwiGLU {
    static constexpr bool PERM = true, AFTER_DRAIN = false;
    bf16_t* O; int ldc;
    __device__ __forceinline__ void operator()(const f32x4 (&acc)[2][2][4][2], const Unit& u, int wr, int wc, int fr, int fq) const {
        const int row0 = u.pm * BM + wr * 64 + fr, col0 = u.pn * HALF + wc * 32 + 8 * fq;
#pragma unroll
        for (int ai = 0; ai < 2; ++ai)
#pragma unroll
            for (int m = 0; m < 4; ++m) {
                float o[8];
#pragma unroll
                for (int n = 0; n < 2; ++n)
#pragma unroll
                    for (int i = 0; i < 4; ++i) { const float a = acc[ai][0][m][n][i], b = acc[ai][1][m][n][i];
                        const float e = __builtin_amdgcn_exp2f(a * -1.4426950408889634f);
                        o[4 * n + i] = (a * b) * __builtin_amdgcn_rcpf(1.0f + e); }
                u32x4 w; w.x = cvt_pk_bf16(o[0], o[1]); w.y = cvt_pk_bf16(o[2], o[3]); w.z = cvt_pk_bf16(o[4], o[5]); w.w = cvt_pk_bf16(o[6], o[7]);
                *(u32x4*)(O + (size_t)(row0 + ai * HALF + m * 16) * ldc + col0) = w; }
    }
};
struct EpiProj {
    static constexpr bool PERM = true, AFTER_DRAIN = false;
    bf16_t* U; bf16_t* QKV;
    __device__ __forceinline__ void operator()(const f32x4 (&acc)[2][2][4][2], const Unit& u, int wr, int wc, int fr, int fq) const {
        const int ct = wc * 32 + 8 * fq;
        if (u.pn < 4) {
            const int row0 = u.pm * BM + wr * 64 + fr;
#pragma unroll
            for (int ai = 0; ai < 2; ++ai)
#pragma unroll
                for (int m = 0; m < 4; ++m) { bf16_t* rowp = U + (size_t)(row0 + ai * HALF + m * 16) * 1024 + u.pn * BM + ct;
#pragma unroll
                    for (int bj = 0; bj < 2; ++bj) { const f32x4 v0 = acc[ai][bj][m][0], v1 = acc[ai][bj][m][1];
                        u32x4 w; w.x = cvt_pk_bf16(v0[0], v0[1]); w.y = cvt_pk_bf16(v0[2], v0[3]); w.z = cvt_pk_bf16(v1[0], v1[1]); w.w = cvt_pk_bf16(v1[2], v1[3]);
                        *(u32x4*)(rowp + bj * HALF) = w; } }
        } else {
            const int t = u.pn - 4, which = t / 12, sl0 = (t % 12) * 2, b = u.pm >> 3, s0 = (u.pm & 7) * BM + wr * 64 + fr;
#pragma unroll
            for (int bj = 0; bj < 2; ++bj) { bf16_t* base = QKV + ((size_t)((which * 4 + b) * 24 + sl0 + bj) * 2048) * 128 + ct;
#pragma unroll
                for (int ai = 0; ai < 2; ++ai)
#pragma unroll
                    for (int m = 0; m < 4; ++m) { const f32x4 v0 = acc[ai][bj][m][0], v1 = acc[ai][bj][m][1];
                        u32x4 w; w.x = cvt_pk_bf16(v0[0], v0[1]); w.y = cvt_pk_bf16(v0[2], v0[3]); w.z = cvt_pk_bf16(v1[0], v1[1]); w.w = cvt_pk_bf16(v1[2], v1[3]);
                        *(u32x4*)(base + (size_t)(s0 + ai * HALF + m * 16) * 128) = w; } }
        }
    }
};
template <class Epi, class Sched, bool ALIGN_EPI = false, bool SP2 = false>
__device__ __forceinline__ void gemm_phase(PG8_LAS unsigned char* lds, const Gemm g, const Sched& S, const Epi& E, const int tid_in) {
    const int tid = tid_in, wid = __builtin_amdgcn_readfirstlane(tid >> 6), lane = tid & 63, wr = wid >> 2, wc = wid & 3, fr = lane & 15, fq = lane >> 4;
    const int K = g.K, nt = K / BK;
    unsigned voffA[2], voffB[2];
#pragma unroll
    for (int i = 0; i < 2; ++i) { int R, C; stage_rc(tid * 16 + i * 8192, R, C); const int Rb = Epi::PERM ? ((R & ~31) + perm32(R & 31)) : R;
        voffA[i] = (unsigned)(R * K + C) * 2u; voffB[i] = (unsigned)(Rb * K + C) * 2u; }
    const size_t kstep = (size_t)(BK * 2);
    const size_t hstep = (size_t)HALF * K * 2;
    const size_t tstep = 2 * hstep;
    const unsigned ldsw = (unsigned)wid * 1024u;
    const int aoff = lds_byte(wr * 64 + fr, fq * 8), boff = lds_byte(wc * 32 + fr, fq * 8);
#define PG8_SA(b, h) (((b) * 2 + (h)) * HTB)
#define PG8_SB(b, h) ((4 + (b) * 2 + (h)) * HTB)
#define PG8_STAGE(bufoff, gbase, voff) do { _Pragma("unroll") for (int _i = 0; _i < 2; ++_i) \
        __builtin_amdgcn_global_load_lds((const unsigned*)((const char*)(gbase) + (voff)[_i]), (PG8_LAS unsigned*)(lds + (bufoff) + ldsw + _i * 8192), 16, 0, 0); } while (0)
#define PG8_LDA(dst, b, h) do { _Pragma("unroll") for (int m = 0; m < 4; ++m) _Pragma("unroll") for (int k = 0; k < 2; ++k) dst[m][k] = *(const PG8_LAS bf16x8*)(lds + PG8_SA(b, h) + aoff + m * 2048 + k * 1024); } while (0)
#define PG8_LDB(dst, b, h) do { _Pragma("unroll") for (int n = 0; n < 2; ++n) _Pragma("unroll") for (int k = 0; k < 2; ++k) dst[n][k] = *(const PG8_LAS bf16x8*)(lds + PG8_SB(b, h) + boff + n * 2048 + k * 1024); } while (0)
#define PG8_MMA(ai, bj, At, Bt) do { __builtin_amdgcn_s_setprio(1); _Pragma("unroll") for (int m = 0; m < 4; ++m) _Pragma("unroll") for (int n = 0; n < 2; ++n) _Pragma("unroll") for (int k = 0; k < 2; ++k) \
        acc[ai][bj][m][n] = __builtin_amdgcn_mfma_f32_16x16x32_bf16(Bt[n][k], At[m][k], acc[ai][bj][m][n], 0, 0, 0); __builtin_amdgcn_s_setprio(0); } while (0)
#define PG8_WAIT_V(n) asm volatile("s_waitcnt vmcnt(" #n ")" ::: "memory")
#define PG8_WAIT_L(n) asm volatile("s_waitcnt lgkmcnt(" #n ")" ::: "memory")
#define PG8_BAR __builtin_amdgcn_s_barrier()
#define PG8_SCHED __builtin_amdgcn_sched_barrier(0)
    Unit cur, nxt; int ui = 0;
    if (!S.next(0, cur)) return;
    f32x4 acc[2][2][4][2];
#pragma unroll
    for (int a = 0; a < 2; ++a)
#pragma unroll
        for (int b = 0; b < 2; ++b)
#pragma unroll
            for (int m = 0; m < 4; ++m)
#pragma unroll
                for (int n = 0; n < 2; ++n) acc[a][b][m][n] = (f32x4){0.f, 0.f, 0.f, 0.f};
    bf16x8 At[4][2], B0[2][2], B1[2][2];
    const char* cA = (const char*)g.A + (size_t)cur.pm * tstep; const char* cB = (const char*)g.Bt + (size_t)cur.pn * tstep;
    S.a_ready(cur);
    if constexpr (SP2) {
        PG8_STAGE(PG8_SB(0, 0), cB, voffB); PG8_STAGE(PG8_SB(0, 1), cB + hstep, voffB); PG8_STAGE(PG8_SA(0, 0), cA, voffA); PG8_STAGE(PG8_SA(0, 1), cA + hstep, voffA);
        if (wr == 1) PG8_BAR;
        PG8_WAIT_V(2); PG8_BAR;
        PG8_STAGE(PG8_SB(1, 0), cB + kstep, voffB); PG8_STAGE(PG8_SA(1, 0), cA + kstep, voffA); PG8_STAGE(PG8_SB(1, 1), cB + hstep + kstep, voffB);
        PG8_WAIT_V(6); PG8_BAR;
    } else {
        PG8_STAGE(PG8_SB(0, 0), cB, voffB); PG8_STAGE(PG8_SA(0, 0), cA, voffA); PG8_STAGE(PG8_SB(0, 1), cB + hstep, voffB); PG8_STAGE(PG8_SA(0, 1), cA + hstep, voffA);
        if (wr == 1) PG8_BAR;
        PG8_WAIT_V(4); PG8_BAR;
        PG8_STAGE(PG8_SB(1, 0), cB + kstep, voffB); PG8_STAGE(PG8_SA(1, 0), cA + kstep, voffA); PG8_STAGE(PG8_SB(1, 1), cB + hstep + kstep, voffB);
        PG8_WAIT_V(6); PG8_BAR;
    }
    for (;;) {
        const bool has_next = S.next(ui + 1, nxt);
        const char* nA = has_next ? (const char*)g.A + (size_t)nxt.pm * tstep : cA; const char* nB = has_next ? (const char*)g.Bt + (size_t)nxt.pn * tstep : cB;
        for (int t = 0; t < nt; t += 2) {
            const bool last = (t == nt - 2);
            const char* a1 = cA + (size_t)(t + 1) * kstep;
            const char* a2 = last ? nA : cA + (size_t)(t + 2) * kstep; const char* b2 = last ? nB : cB + (size_t)(t + 2) * kstep;
            const char* a3 = a2 + kstep; const char* b3 = b2 + kstep;
            if (last && has_next) S.a_ready(nxt);
            if constexpr (SP2) {
            PG8_LDB(B0, 0, 0); PG8_LDB(B1, 0, 1); PG8_SCHED; PG8_LDA(At, 0, 0); PG8_STAGE(PG8_SA(1, 1), a1 + hstep, voffA);
            PG8_WAIT_V(8); PG8_WAIT_L(0); PG8_BAR; PG8_MMA(0, 0, At, B0); PG8_MMA(0, 1, At, B1); PG8_BAR; PG8_SCHED;
            PG8_LDA(At, 0, 1); PG8_STAGE(PG8_SB(0, 0), b2, voffB); PG8_STAGE(PG8_SB(0, 1), b2 + hstep, voffB); PG8_STAGE(PG8_SA(0, 0), a2, voffA);
            PG8_WAIT_V(8); PG8_WAIT_L(0); PG8_BAR; PG8_MMA(1, 0, At, B0); PG8_MMA(1, 1, At, B1); PG8_BAR; PG8_SCHED;
            PG8_LDB(B0, 1, 0); PG8_LDB(B1, 1, 1); PG8_SCHED; PG8_LDA(At, 1, 0); PG8_STAGE(PG8_SA(0, 1), a2 + hstep, voffA);
            PG8_WAIT_V(8); PG8_WAIT_L(0); PG8_BAR; PG8_MMA(0, 0, At, B0); PG8_MMA(0, 1, At, B1); PG8_BAR; PG8_SCHED;
            PG8_LDA(At, 1, 1); PG8_STAGE(PG8_SB(1, 0), b3, voffB); PG8_STAGE(PG8_SB(1, 1), b3 + hstep, voffB); PG8_STAGE(PG8_SA(1, 0), a3, voffA);
            PG8_WAIT_V(8); PG8_WAIT_L(0); PG8_BAR; PG8_MMA(1, 0, At, B0); PG8_MMA(1, 1, At, B1); PG8_BAR; PG8_SCHED;
            } else {
            PG8_LDB(B0, 0, 0); PG8_SCHED; PG8_LDA(At, 0, 0); PG8_STAGE(PG8_SA(1, 1), a1 + hstep, voffA);
            PG8_WAIT_L(8); PG8_BAR; PG8_WAIT_L(0); PG8_MMA(0, 0, At, B0); PG8_BAR; PG8_SCHED;
            PG8_LDB(B1, 0, 1); PG8_STAGE(PG8_SB(0, 0), b2, voffB);
            PG8_BAR; PG8_WAIT_L(0); PG8_MMA(0, 1, At, B1); PG8_BAR;
            PG8_LDA(At, 0, 1); PG8_STAGE(PG8_SA(0, 0), a2, voffA);
            PG8_BAR; PG8_WAIT_L(0); PG8_MMA(1, 0, At, B0); PG8_BAR; PG8_SCHED;
            PG8_STAGE(PG8_SB(0, 1), b2 + hstep, voffB);
            PG8_WAIT_V(6); PG8_BAR; PG8_MMA(1, 1, At, B1); PG8_BAR;
            PG8_LDB(B0, 1, 0); PG8_SCHED; PG8_LDA(At, 1, 0); PG8_STAGE(PG8_SA(0, 1), a2 + hstep, voffA);
            PG8_WAIT_L(8); PG8_BAR; PG8_WAIT_L(0); PG8_MMA(0, 0, At, B0); PG8_BAR; PG8_SCHED;
            PG8_LDB(B1, 1, 1); PG8_STAGE(PG8_SB(1, 0), b3, voffB);
            PG8_BAR; PG8_WAIT_L(0); PG8_MMA(0, 1, At, B1); PG8_BAR;
            PG8_LDA(At, 1, 1); PG8_STAGE(PG8_SA(1, 0), a3, voffA);
            PG8_BAR; PG8_WAIT_L(0); PG8_MMA(1, 0, At, B0); PG8_BAR; PG8_SCHED;
            PG8_STAGE(PG8_SB(1, 1), b3 + hstep, voffB);
            PG8_WAIT_V(6); PG8_BAR; PG8_MMA(1, 1, At, B1); PG8_BAR;
            }
        }
        if constexpr (ALIGN_EPI) { if (wr == 0) PG8_BAR; }
        if constexpr (!Epi::AFTER_DRAIN) { E(acc, cur, wr, wc, fr, fq); S.done(cur); }
        if (!has_next) break;
#pragma unroll
        for (int a = 0; a < 2; ++a)
#pragma unroll
            for (int b = 0; b < 2; ++b)
#pragma unroll
                for (int m = 0; m < 4; ++m)
#pragma unroll
                    for (int n = 0; n < 2; ++n) acc[a][b][m][n] = (f32x4){0.f, 0.f, 0.f, 0.f};
        cur = nxt; cA = nA; cB = nB; ++ui;
        if constexpr (ALIGN_EPI) { if (wr == 1) PG8_BAR; }
    }
    PG8_WAIT_V(0);
    if constexpr (!ALIGN_EPI) { if (wr == 0) PG8_BAR; }
    PG8_BAR;
    if constexpr (Epi::AFTER_DRAIN) { E.fused(acc, cur, wr, wc, fr, fq, lds, wid, lane); S.done(cur); }
#undef PG8_SA
#undef PG8_SB
#undef PG8_STAGE
#undef PG8_LDA
#undef PG8_LDB
#undef PG8_MMA
#undef PG8_WAIT_V
#undef PG8_WAIT_L
#undef PG8_BAR
#undef PG8_SCHED
}
}

namespace attn {
constexpr int D = 128;
constexpr float THR = 8.f;
constexpr bool WSKIP = false;
constexpr float SCALE = 0.08838834764831845f;
constexpr int NW = 8, QBLK = 32, KVBLK = 64, QB = NW * QBLK;
constexpr int SHM_V = KVBLK * D * 2, SHM_K = KVBLK * D * 2;
constexpr int LDS_BYTES = 2 * SHM_V + 2 * SHM_K + NW * 64 * 4;

using bf16 = __hip_bfloat16;
typedef short bf16x8 __attribute__((ext_vector_type(8)));
typedef short s16x4 __attribute__((ext_vector_type(4)));
typedef float f32x16 __attribute__((ext_vector_type(16)));
typedef float f32x4 __attribute__((ext_vector_type(4)));
typedef unsigned u32x4 __attribute__((ext_vector_type(4)));
template <class A, class Bt> struct same_t { static constexpr bool v = false; };
template <class A> struct same_t<A, A> { static constexpr bool v = true; };

#define KSWZ(row, colB) ((row) * 256 + ((colB) ^ (((row) & 7) << 4)))
#define SBAR() __builtin_amdgcn_sched_barrier(0)
__device__ __forceinline__ int v_st(int k, int c) { const int kk = (k & ~0xC) | ((k & 4) << 1) | ((k & 8) >> 1); return ((kk >> 3) * 4 + (c >> 5)) * 512 + ((kk & 7) * 32 + (c & 31)) * 2; }
__device__ __forceinline__ int v_rd_base(int lane) { return ((lane & 3) << 3) | (((lane >> 2) & 3) << 6) | (((lane >> 4) & 1) << 5) | (((lane >> 5) & 1) << 8); }
constexpr int v_rd_off(int d0, int ks, int half) { return d0 * 512 + ks * 4096 + half * 2048; }
__device__ __forceinline__ int crow(int r, int hi) { return (r & 3) + 8 * (r >> 2) + 4 * hi; }
__device__ __forceinline__ unsigned cvtpk(float lo, float hi) {
    unsigned r; asm volatile("v_cvt_pk_bf16_f32 %0, %1, %2" : "=v"(r) : "v"(lo), "v"(hi)); return r;
}
__device__ __forceinline__ bf16x8 pack8(f32x4 a, f32x4 b) {
    u32x4 w = {cvtpk(a[0], a[1]), cvtpk(a[2], a[3]), cvtpk(b[0], b[1]), cvtpk(b[2], b[3])};
    return *reinterpret_cast<bf16x8*>(&w);
}
template <class T> __device__ __forceinline__ bf16x8 load8(const T* p) {
    if constexpr (same_t<T, float>::v) { return pack8(*(const f32x4*)p, *(const f32x4*)(p + 4)); }
    else { return *reinterpret_cast<const bf16x8*>(p); }
}
__device__ __forceinline__ void mask_tile(f32x16& p0, f32x16& p1, int dq, unsigned W) {
    const float NEG = -__builtin_inff();
#pragma unroll
    for (int r = 0; r < 16; ++r) {
        const int c = (r & 3) + 8 * (r >> 2);
        if ((unsigned)(dq - c) >= W) p0[r] = NEG;
        if ((unsigned)(dq - c - 32) >= W) p1[r] = NEG;
    }
}
__device__ __forceinline__ void partialSM(f32x16& p0, f32x16& p1, float& m_reg, float& mn, float& alpha) {
    float pmax = p0[0]; for (int r = 1; r < 16; ++r) pmax = fmaxf(pmax, p0[r]); for (int r = 0; r < 16; ++r) pmax = fmaxf(pmax, p1[r]);
    { auto rr = __builtin_amdgcn_permlane32_swap(__float_as_uint(pmax), __float_as_uint(pmax), false, false);
      pmax = fmaxf(__uint_as_float(rr[0]), __uint_as_float(rr[1])); }
    constexpr float C2 = 1.4426950408889634f * SCALE;
    if (__builtin_expect(__all((pmax - m_reg) * SCALE <= THR), 1)) { mn = m_reg; alpha = 1.f; }
    else { mn = fmaxf(m_reg, pmax); alpha = __builtin_amdgcn_exp2f((m_reg - mn) * C2); m_reg = mn; }
    const float mnL = -mn * C2;
    for (int r = 0; r < 16; ++r) p0[r] = fmaf(p0[r], C2, mnL); for (int r = 0; r < 16; ++r) p1[r] = fmaf(p1[r], C2, mnL);
    for (int r = 0; r < 16; ++r) p0[r] = __builtin_amdgcn_exp2f(p0[r]);
}
__device__ __forceinline__ void finishSM(f32x16& p0, f32x16& p1, float alpha, float& l_reg, bf16x8& pa0, bf16x8& pa1, bf16x8& pa2, bf16x8& pa3) {
    for (int r = 0; r < 16; ++r) p1[r] = __builtin_amdgcn_exp2f(p1[r]);
    float ps = 0; for (int r = 0; r < 16; ++r) ps += p0[r]; for (int r = 0; r < 16; ++r) ps += p1[r];
    { auto rr = __builtin_amdgcn_permlane32_swap(__float_as_uint(ps), __float_as_uint(ps), false, false);
      ps = __uint_as_float(rr[0]) + __uint_as_float(rr[1]); }
    l_reg = l_reg * alpha + ps;
#define PK4(P, B_, OUT) do { unsigned a0 = cvtpk(P[B_+0], P[B_+1]), a1 = cvtpk(P[B_+2], P[B_+3]);                          \
        unsigned b0 = cvtpk(P[B_+4], P[B_+5]), b1 = cvtpk(P[B_+6], P[B_+7]);                                             \
        auto r0 = __builtin_amdgcn_permlane32_swap(a0, b0, false, false); auto r1 = __builtin_amdgcn_permlane32_swap(a1, b1, false, false); \
        u32x4 w = {r0[0], r1[0], r0[1], r1[1]}; OUT = *reinterpret_cast<bf16x8*>(&w); } while (0)
    PK4(p0, 0, pa0); PK4(p0, 8, pa1); PK4(p1, 0, pa2); PK4(p1, 8, pa3);
#undef PK4
}
template <int KB, bool SK>
__device__ __forceinline__ void qkt(f32x16& p0, f32x16& p1, const char* K_lds, int r32, int hi, const bf16x8* qr, bool act) {
    if (SK && !act) { const float NEG = -__builtin_inff();
#pragma unroll
        for (int r = 0; r < 16; ++r) { p0[r] = NEG; p1[r] = NEG; } return; }
    p0 = f32x16{}; p1 = f32x16{};
    const char* kb[4];
#pragma unroll
    for (int dd = 0; dd < 4; ++dd) kb[dd] = K_lds + KB * SHM_K + KSWZ(r32, (dd * 16 + hi * 8) * 2);
#pragma unroll
    for (int d0 = 0; d0 < 8; ++d0) { const char* a = kb[d0 & 3] + (d0 >> 2) * 128;
        bf16x8 b0 = *reinterpret_cast<const bf16x8*>(a);
        bf16x8 b1 = *reinterpret_cast<const bf16x8*>(a + 32 * 256);
        p0 = __builtin_amdgcn_mfma_f32_32x32x16_bf16(b0, qr[d0], p0, 0, 0, 0);
        p1 = __builtin_amdgcn_mfma_f32_32x32x16_bf16(b1, qr[d0], p1, 0, 0, 0); }
}
template <int VB, bool SK>
__device__ __forceinline__ void pv_tile(f32x16* o, int vb0, bf16x8 pa0, bf16x8 pa1, bf16x8 pa2, bf16x8 pa3, bool act) {
    if (SK && !act) return;
#define TRRD(dst, off) asm volatile("ds_read_b64_tr_b16 %0, %1 offset:%2" : "=&v"(dst) : "v"(vb0), "i"(off) : "memory")
#define PV_D0(d0) do { s16x4 l0, l1, l2, l3, h0, h1, h2, h3; constexpr int b_ = VB * SHM_V + v_rd_off(d0, 0, 0);     \
        TRRD(l0, b_); TRRD(h0, b_ + 2048); TRRD(l1, b_ + 4096); TRRD(h1, b_ + 6144); TRRD(l2, b_ + 8192); TRRD(h2, b_ + 10240); TRRD(l3, b_ + 12288); TRRD(h3, b_ + 14336); \
        asm volatile("s_waitcnt lgkmcnt(0)" ::: "memory"); SBAR();                 \
        o[d0] = __builtin_amdgcn_mfma_f32_32x32x16_bf16(pa0, (bf16x8){l0[0], l0[1], l0[2], l0[3], h0[0], h0[1], h0[2], h0[3]}, o[d0], 0, 0, 0);   \
        o[d0] = __builtin_amdgcn_mfma_f32_32x32x16_bf16(pa1, (bf16x8){l1[0], l1[1], l1[2], l1[3], h1[0], h1[1], h1[2], h1[3]}, o[d0], 0, 0, 0);   \
        o[d0] = __builtin_amdgcn_mfma_f32_32x32x16_bf16(pa2, (bf16x8){l2[0], l2[1], l2[2], l2[3], h2[0], h2[1], h2[2], h2[3]}, o[d0], 0, 0, 0);   \
        o[d0] = __builtin_amdgcn_mfma_f32_32x32x16_bf16(pa3, (bf16x8){l3[0], l3[1], l3[2], l3[3], h3[0], h3[1], h3[2], h3[3]}, o[d0], 0, 0, 0); } while (0)
    PV_D0(0); PV_D0(1); PV_D0(2); PV_D0(3);
#undef PV_D0
#undef TRRD
}

template <class TIn, class TOut> struct BlockRef { const TIn* Q; const TIn* K; const TIn* V; TOut* O; int P0; };
template <class TIn> struct Seam {
    bf16x8 qr[8];
    bf16x8 st_v0, st_v1, st_k0, st_k1; f32x4 sf0, sf1, sf2, sf3;
    f32x4 tq[16];
};
__device__ __forceinline__ int swa_jlo(int P0, int W) { const int lowk = P0 - W + 1; return lowk > 0 ? lowk / KVBLK : 0; }
#define ROW(p, k0, rr) ((p) + (size_t)((k0) + (rr)) * D + sc)
#define VMW() asm volatile("s_waitcnt vmcnt(0)" ::: "memory")
#define VMWN(n) asm volatile("s_waitcnt vmcnt(%0)" :: "i"(n) : "memory")
#define SLOAD_H(Kp, Vp, k0) do { S.st_v0 = load8<TIn>(ROW(Vp, k0, sr)); S.st_v1 = load8<TIn>(ROW(Vp, k0, 32 + sr));              \
                         S.st_k0 = load8<TIn>(ROW(Kp, k0, sr)); S.st_k1 = load8<TIn>(ROW(Kp, k0, 32 + sr)); } while (0)
#define SWRITE_HK(bf) do { *(bf16x8*)(K_lds + (bf) * SHM_K + kws) = S.st_k0; *(bf16x8*)(K_lds + (bf) * SHM_K + kws + 32 * 256) = S.st_k1; } while (0)
#define SWRITE_HV(bf) do { *(bf16x8*)(V_lds + (bf) * SHM_V + vst0) = S.st_v0; *(bf16x8*)(V_lds + (bf) * SHM_V + vst1) = S.st_v1; } while (0)
#define SWRITE_H(bf) do { SWRITE_HV(bf); SWRITE_HK(bf); } while (0)
#define SLOAD_F(p, k0) do { S.sf0 = *(const f32x4*)ROW(p, k0, sr); S.sf1 = *(const f32x4*)(ROW(p, k0, sr) + 4);                \
                            S.sf2 = *(const f32x4*)ROW(p, k0, 32 + sr); S.sf3 = *(const f32x4*)(ROW(p, k0, 32 + sr) + 4); } while (0)
#define SWRITE_KF(bf) do { *(bf16x8*)(K_lds + (bf) * SHM_K + kws) = pack8(S.sf0, S.sf1); *(bf16x8*)(K_lds + (bf) * SHM_K + kws + 32 * 256) = pack8(S.sf2, S.sf3); } while (0)
#define SWRITE_VF(bf) do { *(bf16x8*)(V_lds + (bf) * SHM_V + vst0) = pack8(S.sf0, S.sf1); *(bf16x8*)(V_lds + (bf) * SHM_V + vst1) = pack8(S.sf2, S.sf3); } while (0)
template <class TIn, class TOut>
__device__ __forceinline__ void causal_swa_prime(const BlockRef<TIn, TOut>& cur, int W, char* lds, Seam<TIn>& S, const int tid_in) {
    constexpr bool F32 = same_t<TIn, float>::v;
    const int tid = tid_in, wid = __builtin_amdgcn_readfirstlane(tid >> 6), lane = tid & 63, r32 = lane & 31, hi = lane >> 5;
    const int sr = tid >> 4, sc = (tid & 15) * 8, kws = KSWZ(sr, sc * 2); char* K_lds = lds + 2 * SHM_V;
    const int kb0 = swa_jlo(cur.P0, W) * KVBLK;
    for (int d0 = 0; d0 < 8; ++d0) S.qr[d0] = load8<TIn>(cur.Q + (size_t)(wid * QBLK + r32) * D + d0 * 16 + hi * 8);
    if constexpr (F32) { SLOAD_F((const float*)cur.K, kb0); VMW(); SWRITE_KF(0); SBAR(); SLOAD_F((const float*)cur.V, kb0); }
    else { SLOAD_H(cur.K, cur.V, kb0); VMW(); SWRITE_HK(0); }
    __syncthreads();
}
template <class TIn, class TOut>
__device__ __forceinline__ void causal_swa_block(const BlockRef<TIn, TOut>& cur, const BlockRef<TIn, TOut>& nxt, int skv, int W, char* lds, Seam<TIn>& S, const int tid_in) {
    constexpr bool F32 = same_t<TIn, float>::v;
    const int tid = tid_in, wid = __builtin_amdgcn_readfirstlane(tid >> 6), lane = tid & 63, r32 = lane & 31, hi = lane >> 5;
    const int j_lo = swa_jlo(cur.P0, W);
    int j_hi = (cur.P0 + QB - 1) / KVBLK + 1; if (j_hi > skv / KVBLK) j_hi = skv / KVBLK;
    const int NT = j_hi - j_lo;
    const int kbn = swa_jlo(nxt.P0, W) * KVBLK;
    const int qlo = cur.P0 + wid * QBLK, qm = qlo + r32 - 4 * hi;
    char* V_lds = lds; char* K_lds = lds + 2 * SHM_V;
    float* ws = (float*)(lds + 2 * SHM_V + 2 * SHM_K) + wid * 64; float* li_l = ws, * al_l = ws + 32;
    float m_reg = -1e30f, l_reg = 0; f32x16 o[4] = {};
    const int sr = tid >> 4, sc = (tid & 15) * 8, vst0 = v_st(sr, sc), vst1 = v_st(32 + sr, sc), kws = KSWZ(sr, sc * 2);
    const int vb0 = (int)(uintptr_t)V_lds + v_rd_base(lane);
    const TIn* Kh = cur.K; const TIn* Vh = cur.V;
#define RESC(a) do { if (__any((a) < 1.f)) { if (hi == 0) al_l[r32] = (a); asm volatile("s_waitcnt lgkmcnt(0)" ::: "memory");              \
                     for (int d_ = 0; d_ < 4; ++d_) for (int r = 0; r < 16; ++r) o[d_][r] *= al_l[crow(r, hi)]; } } while (0)
#define KBASE(t) ((j_lo + (t)) * KVBLK)
#define ACT(t) (KBASE(t) <= qlo + QBLK - 1 && KBASE(t) + KVBLK - 1 >= qlo - W + 1)
#define MASKT(P0_, P1_, t) do { const int kb_ = KBASE(t); if ((!SK || ACT(t)) && (kb_ + KVBLK - 1 > qlo || kb_ <= qlo + QBLK - 1 - W)) mask_tile(P0_, P1_, qm - kb_, (unsigned)W); } while (0)
    constexpr int NQL = F32 ? 16 : 8;
    constexpr bool SK = WSKIP && !F32;
#define SEAM_K0() do { VMWN(NQL); if constexpr (F32) { SWRITE_KF(0); SBAR(); SLOAD_F((const float*)nxt.V, kbn); } else { SWRITE_HK(0); } SBAR(); } while (0)
    f32x16 pA0, pA1, pB0, pB1; float mnA, mnB, alA, alB; bf16x8 pa0, pa1, pa2, pa3;
    if constexpr (F32) { VMW(); SWRITE_VF(0); SBAR(); } else { SWRITE_HV(0); SBAR(); }
    if (NT > 1) { if constexpr (F32) SLOAD_F((const float*)Kh, KBASE(1)); else SLOAD_H(Kh, Vh, KBASE(1)); }
    SBAR(); qkt<0, SK>(pA0, pA1, K_lds, r32, hi, S.qr, ACT(0));
    if constexpr (F32) { if (NT > 1) { VMW(); SWRITE_KF(1); SBAR(); SLOAD_F((const float*)Vh, KBASE(1)); } }
    MASKT(pA0, pA1, 0); partialSM(pA0, pA1, m_reg, mnA, alA);
    if (NT > 1) { VMW(); if constexpr (F32) { SWRITE_VF(1); SBAR(); if (NT > 2) SLOAD_F((const float*)Kh, KBASE(2)); } else SWRITE_H(1); }
    __syncthreads();
#define HALF_STEP(PX0, PX1, mnX, alX, PY0, PY1, alY, t, KB, VB, SB) do {                                                      \
        SBAR(); qkt<KB, SK>(PX0, PX1, K_lds, r32, hi, S.qr, ACT(t));                                             \
        finishSM(PY0, PY1, alY, l_reg, pa0, pa1, pa2, pa3); SBAR();                                                           \
        if ((t) + 1 < NT) { if constexpr (F32) { VMW(); SWRITE_KF(SB); SBAR(); SLOAD_F((const float*)Vh, KBASE((t) + 1)); }  \
                            else { SLOAD_H(Kh, Vh, KBASE((t) + 1)); } SBAR(); }                                               \
        pv_tile<VB, SK>(o, vb0, pa0, pa1, pa2, pa3, ACT((t) - 1)); MASKT(PX0, PX1, (t)); partialSM(PX0, PX1, m_reg, mnX, alX);                                        \
        __syncthreads();                                                                                                      \
        if ((t) + 1 < NT) { VMW(); if constexpr (F32) { SWRITE_VF(SB); SBAR(); if ((t) + 2 < NT) SLOAD_F((const float*)Kh, KBASE((t) + 2)); } \
                            else { SWRITE_H(SB); } }                                                                          \
        RESC(alX); __syncthreads(); } while (0)
    for (int t = 1; t + 1 < NT; t += 2) {
        HALF_STEP(pB0, pB1, mnB, alB, pA0, pA1, alA, t, 1, 0, 0);
        HALF_STEP(pA0, pA1, mnA, alA, pB0, pB1, alB, t + 1, 0, 1, 1);
    }
    const bool even = (NT & 1) == 0;
    if (even) { SBAR(); qkt<1, SK>(pB0, pB1, K_lds, r32, hi, S.qr, ACT(NT - 1)); SBAR(); }
#define QROW(e) (nxt.Q + (size_t)(wid * QBLK + r32) * D + ((e) >> 1) * 16 + hi * 8 + ((e) & 1) * 4)
    if constexpr (F32) { SLOAD_F((const float*)nxt.K, kbn); SBAR();
#pragma unroll
        for (int e = 0; e < 8; ++e) S.tq[e] = *(const f32x4*)QROW(e); }
    else { SLOAD_H(nxt.K, nxt.V, kbn); SBAR();
#pragma unroll
        for (int d0 = 0; d0 < 8; ++d0) S.qr[d0] = load8<TIn>(nxt.Q + (size_t)(wid * QBLK + r32) * D + d0 * 16 + hi * 8); }
    SBAR();
    finishSM(pA0, pA1, alA, l_reg, pa0, pa1, pa2, pa3); SBAR();
    if constexpr (F32) {
#pragma unroll
        for (int e = 8; e < 16; ++e) S.tq[e] = *(const f32x4*)QROW(e); SBAR(); }
#undef QROW
    pv_tile<0, SK>(o, vb0, pa0, pa1, pa2, pa3, ACT(even ? NT - 2 : NT - 1));
    if (even) { MASKT(pB0, pB1, NT - 1); partialSM(pB0, pB1, m_reg, mnB, alB); __syncthreads(); RESC(alB);
        finishSM(pB0, pB1, alB, l_reg, pa0, pa1, pa2, pa3); SBAR(); pv_tile<1, SK>(o, vb0, pa0, pa1, pa2, pa3, ACT(NT - 1)); }
    SBAR(); SEAM_K0();
    if (hi == 0) li_l[r32] = l_reg; asm volatile("s_waitcnt lgkmcnt(0)" ::: "memory");
    float rli[16];
#pragma unroll
    for (int r = 0; r < 16; ++r) rli[r] = __builtin_amdgcn_rcpf(li_l[crow(r, hi)]);
    TOut* Ow = cur.O + (size_t)(wid * QBLK) * D;
#pragma unroll
    for (int r = 0; r < 16; ++r) { const int orow = crow(r, hi);
#pragma unroll
        for (int d0 = 0; d0 < 4; ++d0) { const float v = o[d0][r] * rli[r];
            if constexpr (same_t<TOut, float>::v) { Ow[(size_t)orow * D + d0 * 32 + r32] = v; }
            else { const float vn = __shfl_xor(v, 1);
                   if ((r32 & 1) == 0) *(unsigned*)(Ow + (size_t)orow * D + d0 * 32 + r32) = cvtpk(v, vn); } } }
    if constexpr (F32) {
#pragma unroll
        for (int d0 = 0; d0 < 8; ++d0) S.qr[d0] = pack8(S.tq[2 * d0], S.tq[2 * d0 + 1]); }
    __syncthreads();
#undef RESC
#undef KBASE
#undef ACT
#undef MASKT
#undef SEAM_K0
#undef HALF_STEP
}
#undef ROW
#undef VMW
#undef VMWN
#undef SLOAD_H
#undef SWRITE_HK
#undef SWRITE_HV
#undef SWRITE_H
#undef SLOAD_F
#undef SWRITE_KF
#undef SWRITE_VF
}
#define GAS __attribute__((address_space(1)))
#define LAS __attribute__((address_space(3)))
typedef unsigned short bf16;
typedef unsigned v4u __attribute__((ext_vector_type(4)));
typedef float f32x4 __attribute__((ext_vector_type(4)));
typedef short bf16x8 __attribute__((ext_vector_type(8)));
typedef GAS unsigned gu32;
typedef GAS unsigned long long gu64;
#define RLX_AGENT __ATOMIC_RELAXED, __HIP_MEMORY_SCOPE_AGENT
#define LDS_WAIT() asm volatile("s_waitcnt lgkmcnt(0)" ::: "memory")
#define VM_WAIT() asm volatile("s_waitcnt vmcnt(0)" ::: "memory")
__device__ __forceinline__ unsigned long long rt() { return __builtin_amdgcn_s_memrealtime(); }
__device__ __forceinline__ unsigned f2bf(float f) { unsigned u = __builtin_bit_cast(unsigned, f); return (u + 0x7fffu + ((u >> 16) & 1u)) >> 16; }
__device__ __forceinline__ unsigned pk2(float lo, float hi) { return f2bf(lo) | (f2bf(hi) << 16); }

#define XB_TMO      128
#define XB_XCNT(j)  (256  + 64 * (j))
#define XB_XSUB(j)  (1280 + 64 * (j))
#define XB_XGEN(j)  (2304 + 64 * (j))
#define XB_TOP      3328
#define XB_TOPGEN   3392
#define XCD_BAR_WORDS 3456
#define XB_SPIN_CAP (1u << 18)

__device__ __forceinline__ unsigned xb_ld(unsigned* p)              { return __hip_atomic_load(p, __ATOMIC_RELAXED, __HIP_MEMORY_SCOPE_AGENT); }
__device__ __forceinline__ unsigned xb_add(unsigned* p, unsigned v) { return __hip_atomic_fetch_add(p, v, __ATOMIC_RELAXED, __HIP_MEMORY_SCOPE_AGENT); }
__device__ __forceinline__ unsigned xb_xcc_id() { return (unsigned)__builtin_amdgcn_s_getreg((3 << 11) | 20) & 0xFu; }
#define XB_SPIN(cond, bar) do { unsigned _sp = 0; while (cond) { __builtin_amdgcn_s_sleep(1); \
    if ((++_sp & 255u) == 0u) { if (xb_ld(&(bar)[XB_TMO])) break; if (_sp > XB_SPIN_CAP) { atomicAdd(&(bar)[XB_TMO], 1u); break; } } } } while (0)

struct XcdBarrier {
    unsigned* bar; unsigned x;
    volatile LAS unsigned* st;
};

__device__ __forceinline__ XcdBarrier xcd_barrier_post(unsigned* bar, volatile LAS unsigned* st) {
    XcdBarrier b; b.bar = bar; b.x = xb_xcc_id(); b.st = st;
    if (threadIdx.x == 0) (void)xb_add(&bar[XB_XCNT(b.x)], 1u);
    return b;
}
__device__ __forceinline__ void xcd_barrier_complete(unsigned* bar, unsigned x, unsigned& nloc, unsigned& nx) {
    const unsigned G = gridDim.x * gridDim.y * gridDim.z;
    unsigned sum, cnt, mine, sp = 0u;
    for (;;) {
        sum = 0u; cnt = 0u; mine = 0u;
#pragma unroll
        for (unsigned j = 0; j < 16; ++j) { const unsigned c = xb_ld(&bar[XB_XCNT(j)]); sum += c; cnt += (c > 0u) ? 1u : 0u; mine = (j == x) ? c : mine; }
        if (sum == G) break;
        __builtin_amdgcn_s_sleep(1);
        if ((++sp & 255u) == 0u) { if (xb_ld(&bar[XB_TMO])) break; if (sp > XB_SPIN_CAP) { atomicAdd(&bar[XB_TMO], 1u); break; } }
    }
    nloc = mine > 0u ? mine : 1u; nx = cnt > 0u ? cnt : 1u;
}

__device__ __forceinline__ void xcd_barrier(const XcdBarrier& b, const int tid_in) {
    asm volatile("s_waitcnt vmcnt(0)" ::: "memory");
    __syncthreads();
    if (tid_in == 0) {
        unsigned* bar = b.bar;
        __builtin_amdgcn_s_waitcnt(0);
        unsigned nloc = b.st[0], nx = b.st[1];
        if (nloc == 0u) { xcd_barrier_complete(bar, b.x, nloc, nx); b.st[0] = nloc; b.st[1] = nx; }
        const unsigned old = xb_add(&bar[XB_XSUB(b.x)], 1u);
        const unsigned gen = old / nloc;
        if (old + 1u == (gen + 1u) * nloc) {
            __builtin_amdgcn_fence(__ATOMIC_RELEASE, "agent");
            asm volatile("s_waitcnt vmcnt(0)" ::: "memory");
            const unsigned og = xb_add(&bar[XB_TOP], 1u);
            const unsigned tg = og / nx;
            if (og + 1u == (tg + 1u) * nx) xb_add(&bar[XB_TOPGEN], 1u);
            else XB_SPIN(xb_ld(&bar[XB_TOPGEN]) == tg, bar);
            __builtin_amdgcn_fence(__ATOMIC_ACQUIRE, "agent");
            xb_add(&bar[XB_XGEN(b.x)], 1u);
            asm volatile("s_waitcnt vmcnt(0)" ::: "memory");
        } else {
            XB_SPIN(xb_ld(&bar[XB_XGEN(b.x)]) == gen, bar);
            __builtin_amdgcn_fence(__ATOMIC_ACQUIRE, "agent");
            asm volatile("s_waitcnt vmcnt(0)" ::: "memory");
        }
    }
    __syncthreads();
}

constexpr int NWAVES = 8;
#ifndef MK_N_LAUNCHES
#define MK_N_LAUNCHES 13
#endif
constexpr int N_PHASES = 13;
constexpr int N_LAUNCHES = MK_N_LAUNCHES;
static_assert(N_LAUNCHES == 1 || N_LAUNCHES == N_PHASES, "MK_N_LAUNCHES is 1 or 13");
constexpr int NB = 4, SEQ = 2048, DM = 4096, M = NB * SEQ, DFF = 11008, DPOOL = 1024, NH = 12, DIN = 10240, NMOD = 9 * DM;
constexpr float EPS = 1e-6f;
constexpr float ONE_MINUS_LAMBDA_INIT = 0.8f, LAMBDA_INIT = 0.2f;

constexpr size_t MiB = 1u << 20;
constexpr size_t WS_CTL = 0, CTL_ZERO_BYTES = 1 * MiB;
constexpr size_t WS_MOD = 1 * MiB;
constexpr size_t WS_WPT = 2 * MiB;
constexpr size_t WS_W13A = 4 * MiB, WS_W2A = 176 * MiB, WS_W13B = 262 * MiB, WS_W2B = 434 * MiB, WS_WIN = 520 * MiB, WS_WOUT = 600 * MiB;
constexpr size_t WS_XN = 632 * MiB;
constexpr size_t WS_ACT = 696 * MiB;
constexpr size_t WS_F = 868 * MiB;
constexpr size_t WS_U = 996 * MiB;
constexpr size_t WS_QKV = 1012 * MiB;
constexpr size_t WS_O4 = 1156 * MiB;
constexpr size_t WS_MIX = 1252 * MiB;
constexpr size_t WS_END = 1316 * MiB;
static_assert(WS_W13A + (size_t)2 * DFF * DM * 2 <= WS_W2A && WS_W2A + (size_t)DFF * DM * 2 <= WS_W13B && WS_W13B + (size_t)2 * DFF * DM * 2 <= WS_W2B && WS_W2B + (size_t)DFF * DM * 2 <= WS_WIN, "ws map 1");
static_assert(WS_WIN + (size_t)DIN * DM * 2 <= WS_WOUT && WS_WOUT + (size_t)DM * DM * 2 <= WS_XN && WS_XN + (size_t)M * DM * 2 <= WS_ACT && WS_ACT + (size_t)M * DFF * 2 <= WS_F && WS_F + (size_t)M * DM * 4 <= WS_U, "ws map 2");
static_assert(WS_U + (size_t)M * DPOOL * 2 <= WS_QKV && WS_QKV + (size_t)3 * M * 3072 * 2 <= WS_O4 && WS_O4 + (size_t)M * 6144 * 2 <= WS_MIX && WS_MIX + (size_t)M * DM * 2 <= WS_END, "ws map 3");
constexpr int CW_BAR = 4096;

constexpr int RING_OFF = 0, RING_BYTES = 131072;
constexpr int LDSCTL_OFF = RING_BYTES, MISC_OFF = LDSCTL_OFF + 320;
constexpr int LDS_BYTES = 147456;
static_assert(MISC_OFF + 128 <= LDS_BYTES, "LDS map");

__device__ __forceinline__ float wave_sum(float v) {
#pragma unroll
    for (int o = 1; o < 64; o <<= 1) v += __shfl_xor(v, o);
    return v;
}
__device__ __forceinline__ float bf_lo(unsigned w) { return __uint_as_float(w << 16); }
__device__ __forceinline__ float bf_hi(unsigned w) { return __uint_as_float(w & 0xffff0000u); }

__device__ __forceinline__ void p0_adaln(const float* c, const float* w_ada, const float* b_ada, float* mod, LAS unsigned char* lds, int wg, int G, int tid) {
    LAS float* sil = (LAS float*)lds;
    LAS float* red = (LAS float*)(lds + 65536);
    for (int i = tid; i < NB * DM; i += NWAVES * 64) { const int b = i / DM, k = i % DM; const float v = c[i]; sil[k * 4 + b] = v / (1.f + __expf(-v)); }
    __syncthreads();
    const int wave = tid >> 6, lane = tid & 63;
    for (int ch = wg; ch < 256; ch += G) {
        const int j0 = ch * 144;
        if (lane < 36) {
            f32x4 a0 = {0.f, 0.f, 0.f, 0.f}, a1 = a0, a2 = a0, a3 = a0;
            const float* wp = w_ada + (size_t)(wave * 512) * NMOD + j0 + 4 * lane;
            const LAS float* sp = sil + wave * 512 * 4;
            for (int k = 0; k < 512; k += 8) {
                f32x4 w[8];
#pragma unroll
                for (int u = 0; u < 8; ++u) w[u] = *(const GAS f32x4*)(wp + (size_t)(k + u) * NMOD);
#pragma unroll
                for (int u = 0; u < 8; ++u) { const f32x4 s = *(const LAS f32x4*)(sp + (k + u) * 4); a0 += w[u] * s.x; a1 += w[u] * s.y; a2 += w[u] * s.z; a3 += w[u] * s.w; }
            }
            LAS float* r = red + wave * 576 + 4 * lane;
            *(LAS f32x4*)(r) = a0; *(LAS f32x4*)(r + 144) = a1; *(LAS f32x4*)(r + 288) = a2; *(LAS f32x4*)(r + 432) = a3;
        }
        __syncthreads();
        for (int o = tid; o < 576; o += NWAVES * 64) { const int b = o / 144, col = o % 144; float s = 0.f;
#pragma unroll
            for (int w = 0; w < 8; ++w) s += red[w * 576 + o];
            mod[b * NMOD + j0 + col] = s + b_ada[j0 + col]; }
        __syncthreads();
    }
}
__device__ __forceinline__ void p0_transpose_item(const float* W, int K, int N, bf16* WT, int mode, LAS float* scr, int item, int lane) {
    const int nblk = N / 32, kb = item / nblk, nb = item % nblk, k0 = 64 * kb, n0 = 32 * nb;
    const int orow0 = mode == 0 ? n0 : (256 * (n0 >> 7) + (n0 & 127) + 128 * (mode - 1));
#pragma unroll 8
    for (int i = 0; i < 32; ++i) { const int kk = 2 * i + (lane >> 5); scr[kk * 33 + (lane & 31)] = W[(size_t)(k0 + kk) * N + n0 + (lane & 31)]; }
    LDS_WAIT(); asm volatile("" ::: "memory");
    const int c = lane & 7;
#pragma unroll
    for (int j = 0; j < 4; ++j) { const int n = (lane >> 3) + 8 * j; const LAS float* s = scr + (8 * c) * 33 + n;
        v4u o; o.x = pk2(s[0 * 33], s[1 * 33]); o.y = pk2(s[2 * 33], s[3 * 33]); o.z = pk2(s[4 * 33], s[5 * 33]); o.w = pk2(s[6 * 33], s[7 * 33]);
        *(GAS v4u*)(WT + (size_t)(orow0 + n) * K + k0 + 8 * c) = o; }
    LDS_WAIT(); asm volatile("" ::: "memory");
}
struct WPtrs { const float *f1w1, *f1w3, *f1w2, *f2w1, *f2w3, *f2w2, *win, *wout, *wpool; bf16 *W13A, *W2A, *W13B, *W2B, *WIN, *WOUT, *WPT; };
__device__ __forceinline__ void p0_convert(const WPtrs& P, LAS unsigned char* lds, int gw, int NGW, int wave, int lane) {
    LAS float* scr = (LAS float*)(lds + wave * 16384);
    constexpr int I_UP = (DM / 64) * (DFF / 32), I_DN = (DFF / 64) * (DM / 32), I_IN = (DM / 64) * (DIN / 32), I_OUT = (DM / 64) * (DM / 32), I_PL = (256 / 64) * (256 / 32);
    constexpr int NITEMS = 4 * I_UP + 2 * I_DN + I_IN + I_OUT + 4 * I_PL;
    for (int it = gw; it < NITEMS; it += NGW) {
        int r = it;
        if (r < I_UP) { p0_transpose_item(P.f1w1, DM, DFF, P.W13A, 1, scr, r, lane); continue; } r -= I_UP;
        if (r < I_UP) { p0_transpose_item(P.f1w3, DM, DFF, P.W13A, 2, scr, r, lane); continue; } r -= I_UP;
        if (r < I_DN) { p0_transpose_item(P.f1w2, DFF, DM, P.W2A, 0, scr, r, lane); continue; } r -= I_DN;
        if (r < I_IN) { p0_transpose_item(P.win, DM, DIN, P.WIN, 0, scr, r, lane); continue; } r -= I_IN;
        if (r < I_OUT) { p0_transpose_item(P.wout, DM, DM, P.WOUT, 0, scr, r, lane); continue; } r -= I_OUT;
        if (r < 4 * I_PL) { const int g = r / I_PL; p0_transpose_item(P.wpool + (size_t)g * 65536, 256, 256, P.WPT + (size_t)g * 65536, 0, scr, r % I_PL, lane); continue; } r -= 4 * I_PL;
        if (r < I_UP) { p0_transpose_item(P.f2w1, DM, DFF, P.W13B, 1, scr, r, lane); continue; } r -= I_UP;
        if (r < I_UP) { p0_transpose_item(P.f2w3, DM, DFF, P.W13B, 2, scr, r, lane); continue; } r -= I_UP;
        p0_transpose_item(P.f2w2, DFF, DM, P.W2B, 0, scr, r, lane);
    }
}

__device__ __forceinline__ float sumsq4(f32x4 v) { return (v.x * v.x + v.y * v.y) + (v.z * v.z + v.w * v.w); }
__device__ __forceinline__ __amdgpu_buffer_rsrc_t mkrsrc(const void* p, unsigned bytes) {
    const unsigned long long a = (unsigned long long)p;
    const unsigned lo = __builtin_amdgcn_readfirstlane((unsigned)a), hi = __builtin_amdgcn_readfirstlane((unsigned)(a >> 32));
    return __builtin_amdgcn_make_buffer_rsrc((void*)(((unsigned long long)hi << 32) | lo), 0, bytes, 0x00020000);
}
#define RP_LD4(rs, j) __builtin_bit_cast(f32x4, __builtin_amdgcn_raw_buffer_load_b128((rs), lo16, 1024 * (j), 0))
#define RP_ST4(rs, j, val) __builtin_amdgcn_raw_buffer_store_b128(__builtin_bit_cast(v4u, (val)), (rs), lo16, 1024 * (j), 0)
#define RP_ST8(rs, j, a, b) __builtin_amdgcn_raw_buffer_store_b64((v2u){(a), (b)}, (rs), lo8, 512 * (j), 0)
typedef unsigned v2u __attribute__((ext_vector_type(2)));
__device__ __forceinline__ void rowpass_first(const float* x, const float* g, const float* mod_sub  , bf16* XN, int gw, int NGW, int lane) {
    const int lo16 = lane * 16, lo8 = lane * 8;
    const __amdgpu_buffer_rsrc_t rg = mkrsrc(g, DM * 4);
    for (int m = gw; m < M; m += NGW) {
        const int b = m / SEQ;
        const __amdgpu_buffer_rsrc_t rx = mkrsrc(x + (size_t)m * DM, DM * 4), rsh = mkrsrc(mod_sub + (size_t)b * NMOD, DM * 4), rsc = mkrsrc(mod_sub + (size_t)b * NMOD + DM, DM * 4), ro = mkrsrc(XN + (size_t)m * DM, DM * 2);
        f32x4 v[16]; float ss = 0.f;
#pragma unroll
        for (int j = 0; j < 16; ++j) { v[j] = RP_LD4(rx, j); ss += sumsq4(v[j]); }
        const float rstd = 1.f / sqrtf(wave_sum(ss) * (1.f / DM) + EPS);
#pragma unroll
        for (int j = 0; j < 16; ++j) { const f32x4 gg = RP_LD4(rg, j), sh = RP_LD4(rsh, j), sc = RP_LD4(rsc, j);
            const f32x4 h = (v[j] * rstd * gg) * (sc + 1.0f) + sh;
            RP_ST8(ro, j, pk2(h.x, h.y), pk2(h.z, h.w)); }
    }
}
__device__ __forceinline__ void rowpass_mid(const float* F, const float* xi, float* xo, bf16* XN, const float* gpost, const float* gpre, const float* mod_cur  ,
                                            const float* mod_nxt  , float gmul, int gw, int NGW, int lane) {
    const int lo16 = lane * 16, lo8 = lane * 8;
    const __amdgpu_buffer_rsrc_t rgpo = mkrsrc(gpost, DM * 4), rgpr = mkrsrc(gpre, DM * 4);
    for (int m = gw; m < M; m += NGW) {
        const int b = m / SEQ;
        const __amdgpu_buffer_rsrc_t rf_ = mkrsrc(F + (size_t)m * DM, DM * 4), rx = mkrsrc(xi + (size_t)m * DM, DM * 4), rw = mkrsrc(xo + (size_t)m * DM, DM * 4), ro = mkrsrc(XN + (size_t)m * DM, DM * 2);
        const __amdgpu_buffer_rsrc_t rga = mkrsrc(mod_cur + (size_t)b * NMOD + 2 * DM, DM * 4), rsh = mkrsrc(mod_nxt + (size_t)b * NMOD, DM * 4), rsc = mkrsrc(mod_nxt + (size_t)b * NMOD + DM, DM * 4);
        f32x4 f[16], v[16]; float ss = 0.f;
#pragma unroll
        for (int j = 0; j < 16; ++j) { f[j] = RP_LD4(rf_, j); ss += sumsq4(f[j]); }
#pragma unroll
        for (int j = 0; j < 16; ++j) v[j] = RP_LD4(rx, j);
        const float rf = gmul / sqrtf(wave_sum(ss) * (1.f / DM) + EPS);
        float s2 = 0.f;
#pragma unroll
        for (int j = 0; j < 16; ++j) { const f32x4 gg = RP_LD4(rgpo, j), ga = RP_LD4(rga, j); v[j] = v[j] + ga * (f[j] * rf * gg); RP_ST4(rw, j, v[j]); s2 += sumsq4(v[j]); }
        const float rstd = 1.f / sqrtf(wave_sum(s2) * (1.f / DM) + EPS);
#pragma unroll
        for (int j = 0; j < 16; ++j) { const f32x4 gg = RP_LD4(rgpr, j), sh = RP_LD4(rsh, j), sc = RP_LD4(rsc, j);
            const f32x4 h = (v[j] * rstd * gg) * (sc + 1.0f) + sh;
            RP_ST8(ro, j, pk2(h.x, h.y), pk2(h.z, h.w)); }
    }
}
__device__ __forceinline__ void rowpass_last(const float* F, const float* xi, float* xo, const float* gpost, const float* mod_cur, float gmul, int gw, int NGW, int lane) {
    const int lo16 = lane * 16;
    const __amdgpu_buffer_rsrc_t rgpo = mkrsrc(gpost, DM * 4);
    for (int m = gw; m < M; m += NGW) {
        const int b = m / SEQ;
        const __amdgpu_buffer_rsrc_t rf_ = mkrsrc(F + (size_t)m * DM, DM * 4), rx = mkrsrc(xi + (size_t)m * DM, DM * 4), rw = mkrsrc(xo + (size_t)m * DM, DM * 4);
        const __amdgpu_buffer_rsrc_t rga = mkrsrc(mod_cur + (size_t)b * NMOD + 2 * DM, DM * 4);
        f32x4 f[16], v[16]; float ss = 0.f;
#pragma unroll
        for (int j = 0; j < 16; ++j) { f[j] = RP_LD4(rf_, j); ss += sumsq4(f[j]); }
#pragma unroll
        for (int j = 0; j < 16; ++j) v[j] = RP_LD4(rx, j);
        const float rf = gmul / sqrtf(wave_sum(ss) * (1.f / DM) + EPS);
#pragma unroll
        for (int j = 0; j < 16; ++j) { const f32x4 gg = RP_LD4(rgpo, j), ga = RP_LD4(rga, j); RP_ST4(rw, j, v[j] + ga * (f[j] * rf * gg)); }
    }
}

__device__ __forceinline__ void pool_task(const bf16* U, const bf16* WPT, const float* pool_scale, bf16* MIX, int task, int lane) {
    const int g = task & 3, rb = task >> 2, w = 2 << g, fr = lane & 15, fq = lane >> 4, t = rb * 16 + fr, ts = t & (SEQ - 1);
    const int cnt = (ts + 1) < w ? (ts + 1) : w; const float inv = 1.f / (float)cnt;
    f32x4 acc[16];
#pragma unroll
    for (int n = 0; n < 16; ++n) acc[n] = (f32x4){0.f, 0.f, 0.f, 0.f};
    const bf16* up = U + (size_t)t * DPOOL + g * 256 + 8 * fq;
    const bf16* wp = WPT + (size_t)g * 65536 + (size_t)fr * 256 + 8 * fq;
    for (int ks = 0; ks < 8; ++ks) {
        float s[8];
#pragma unroll
        for (int i = 0; i < 8; ++i) s[i] = 0.f;
        for (int j = 0; j < w; ++j) {
            if (j < cnt) { const v4u r = *(const GAS v4u*)(up + ks * 32 - (size_t)j * DPOOL);
                s[0] += bf_lo(r.x); s[1] += bf_hi(r.x); s[2] += bf_lo(r.y); s[3] += bf_hi(r.y); s[4] += bf_lo(r.z); s[5] += bf_hi(r.z); s[6] += bf_lo(r.w); s[7] += bf_hi(r.w); }
        }
        const v4u own = *(const GAS v4u*)(up + ks * 32);
        v4u aw;
        aw.x = pk2(s[0] * inv - bf_lo(own.x), s[1] * inv - bf_hi(own.x)); aw.y = pk2(s[2] * inv - bf_lo(own.y), s[3] * inv - bf_hi(own.y));
        aw.z = pk2(s[4] * inv - bf_lo(own.z), s[5] * inv - bf_hi(own.z)); aw.w = pk2(s[6] * inv - bf_lo(own.w), s[7] * inv - bf_hi(own.w));
        const bf16x8 af = __builtin_bit_cast(bf16x8, aw);
#pragma unroll
        for (int n = 0; n < 16; ++n) { const bf16x8 bfr = *(const GAS bf16x8*)(wp + (size_t)n * 16 * 256 + ks * 32);
            acc[n] = __builtin_amdgcn_mfma_f32_16x16x32_bf16(bfr, af, acc[n], 0, 0, 0); }
    }
    bf16* op = MIX + (size_t)t * DM + g * 256 + 4 * fq; const float* psp = pool_scale + g * 256 + 4 * fq;
#pragma unroll
    for (int n = 0; n < 16; ++n) { const f32x4 ps = *(const GAS f32x4*)(psp + n * 16); const f32x4 o = acc[n] * ps;
        *(GAS unsigned long long*)(op + n * 16) = (unsigned long long)pk2(o.x, o.y) | ((unsigned long long)pk2(o.z, o.w) << 32); }
}

__device__ __forceinline__ void combine_phase(const bf16* O4, const float* subln_g, const float* lq1, const float* lk1, const float* lq2, const float* lk2, bf16* MIX, int gw, int NGW, int lane) {
    const float s1 = wave_sum(lq1[lane] * lk1[lane] + lq1[lane + 64] * lk1[lane + 64]), s2 = wave_sum(lq2[lane] * lk2[lane] + lq2[lane + 64] * lk2[lane + 64]);
    const float lam = __expf(s1) - __expf(s2) + LAMBDA_INIT;
    const int l16 = lane & 15, hq = lane >> 4, half = l16 >> 3, e0 = (l16 & 7) * 16;
    f32x4 gsub[4];
#pragma unroll
    for (int i = 0; i < 4; ++i) gsub[i] = *(const GAS f32x4*)(subln_g + half * 128 + e0 + 4 * i) * ONE_MINUS_LAMBDA_INIT;
    for (int task = gw; task < M * 3; task += NGW) {
        const int t = task / 3, h = (task % 3) * 4 + hq, b = t / SEQ, s = t % SEQ;
        const bf16* p1 = O4 + ((((size_t)(b * NH + h) * 2 + 0) * 2 + half) * SEQ + s) * 128 + e0;
        const bf16* p2 = p1 + (size_t)2 * SEQ * 128;
        const v4u a0 = *(const GAS v4u*)p1, a1 = *(const GAS v4u*)(p1 + 8), c0 = *(const GAS v4u*)p2, c1 = *(const GAS v4u*)(p2 + 8);
        float o[16];
        o[0] = bf_lo(a0.x) - lam * bf_lo(c0.x); o[1] = bf_hi(a0.x) - lam * bf_hi(c0.x); o[2] = bf_lo(a0.y) - lam * bf_lo(c0.y); o[3] = bf_hi(a0.y) - lam * bf_hi(c0.y);
        o[4] = bf_lo(a0.z) - lam * bf_lo(c0.z); o[5] = bf_hi(a0.z) - lam * bf_hi(c0.z); o[6] = bf_lo(a0.w) - lam * bf_lo(c0.w); o[7] = bf_hi(a0.w) - lam * bf_hi(c0.w);
        o[8] = bf_lo(a1.x) - lam * bf_lo(c1.x); o[9] = bf_hi(a1.x) - lam * bf_hi(c1.x); o[10] = bf_lo(a1.y) - lam * bf_lo(c1.y); o[11] = bf_hi(a1.y) - lam * bf_hi(c1.y);
        o[12] = bf_lo(a1.z) - lam * bf_lo(c1.z); o[13] = bf_hi(a1.z) - lam * bf_hi(c1.z); o[14] = bf_lo(a1.w) - lam * bf_lo(c1.w); o[15] = bf_hi(a1.w) - lam * bf_hi(c1.w);
        float ss = 0.f;
#pragma unroll
        for (int i = 0; i < 16; ++i) ss += o[i] * o[i];
        ss += __shfl_xor(ss, 1); ss += __shfl_xor(ss, 2); ss += __shfl_xor(ss, 4); ss += __shfl_xor(ss, 8);
        const float rstd = 1.f / sqrtf(ss * (1.f / 256.f) + EPS);
        v4u w0, w1;
        w0.x = pk2(o[0] * rstd * gsub[0].x, o[1] * rstd * gsub[0].y); w0.y = pk2(o[2] * rstd * gsub[0].z, o[3] * rstd * gsub[0].w);
        w0.z = pk2(o[4] * rstd * gsub[1].x, o[5] * rstd * gsub[1].y); w0.w = pk2(o[6] * rstd * gsub[1].z, o[7] * rstd * gsub[1].w);
        w1.x = pk2(o[8] * rstd * gsub[2].x, o[9] * rstd * gsub[2].y); w1.y = pk2(o[10] * rstd * gsub[2].z, o[11] * rstd * gsub[2].w);
        w1.z = pk2(o[12] * rstd * gsub[3].x, o[13] * rstd * gsub[3].y); w1.w = pk2(o[14] * rstd * gsub[3].z, o[15] * rstd * gsub[3].w);
        bf16* op = MIX + (size_t)t * DM + DPOOL + h * 256 + half * 128 + e0;
        *(GAS v4u*)op = w0; *(GAS v4u*)(op + 8) = w1;
    }
}

__device__ __forceinline__ attn::BlockRef<attn::bf16, attn::bf16> attn_ref(const bf16* QKV, bf16* O4, int L, int pass) {
    const int x = L & 3, vh = L >> 2, half = vh & 1, map = (vh >> 1) & 1, bh = vh >> 2, b = bh / NH, h = bh % NH, qb = pass ? 7 - x : x;
    constexpr size_t SL = (size_t)SEQ * 128;
    attn::BlockRef<attn::bf16, attn::bf16> r;
    r.Q = (const attn::bf16*)QKV + ((size_t)((0 * 4 + b) * 24 + h * 2 + map)) * SL + (size_t)qb * 256 * 128;
    r.K = (const attn::bf16*)QKV + ((size_t)((1 * 4 + b) * 24 + h * 2 + map)) * SL;
    r.V = (const attn::bf16*)QKV + ((size_t)((2 * 4 + b) * 24 + h * 2 + half)) * SL;
    r.O = (attn::bf16*)O4 + ((size_t)(((b * NH + h) * 2 + map) * 2 + half)) * SL + (size_t)qb * 256 * 128;
    r.P0 = qb * 256;
    return r;
}
__device__ __forceinline__ void attn_phase(const bf16* QKV, bf16* O4, char* lds, int vcu, int G, const int tid) {
    constexpr int NITEMS = NB * NH * 2 * 2 * 4;
    const int per = (NITEMS + G - 1) / G, L0 = vcu * per, L1 = (L0 + per) < NITEMS ? (L0 + per) : NITEMS;
    if (L0 >= L1) return;
    int L = L0, pass = 0;
    attn::BlockRef<attn::bf16, attn::bf16> cur = attn_ref(QKV, O4, L, 0);
    attn::Seam<attn::bf16> S;
    attn::causal_swa_prime<attn::bf16, attn::bf16>(cur, SEQ, lds, S, tid);
    for (;;) {
        const bool more_pass = pass == 0, more_item = L + 1 < L1, last = !more_pass && !more_item;
        int passn = pass + 1, Ln = L;
        if (!more_pass) { passn = 0; Ln = more_item ? L + 1 : L; }
        const attn::BlockRef<attn::bf16, attn::bf16> nxt = last ? cur : attn_ref(QKV, O4, Ln, passn);
        attn::causal_swa_block<attn::bf16, attn::bf16>(cur, nxt, SEQ, SEQ, lds, S, tid);
        if (last) break;
        cur = nxt; pass = passn; L = Ln;
    }
}

struct Args { const float* in[21]; float* out; unsigned char* ws; int ph_lo, ph_hi; };
static_assert(sizeof(Args) == 24 * 8, "Args has no holes");
__global__ void __launch_bounds__(NWAVES * 64, 2) mk_fwd(Args args) {
    extern __shared__ __attribute__((aligned(16))) unsigned char lds[];
    LAS unsigned char* ldsl = (LAS unsigned char*)lds;
    volatile LAS unsigned* MISC = (volatile LAS unsigned*)(ldsl + MISC_OFF);
    const int wave = __builtin_amdgcn_readfirstlane(threadIdx.x >> 6);
#define MK_LANE() ({ int l_; asm volatile("v_mbcnt_lo_u32_b32 %0, -1, 0\n\tv_mbcnt_hi_u32_b32 %0, -1, %0" : "=v"(l_)); l_; })
    const int G = gridDim.x, bx = blockIdx.x, vcu = (G % 8 == 0) ? (bx % 8) * (G / 8) + bx / 8 : bx;
    const int gw = vcu * NWAVES + wave, NGW = G * NWAVES;
    unsigned char* ws = args.ws;
    gu32* ctl = (gu32*)(ws + WS_CTL);
    const float *x = args.in[0], *c = args.in[1], *w_ada = args.in[2], *b_ada = args.in[3], *pre_g = args.in[4], *post_g = args.in[5];
    const float *pool_scale = args.in[11], *lq1 = args.in[12], *lk1 = args.in[13], *lq2 = args.in[14], *lk2 = args.in[15], *subln_g = args.in[16];
    float* out = args.out;
    float* mod = (float*)(ws + WS_MOD);
    bf16 *WPT = (bf16*)(ws + WS_WPT), *W13A = (bf16*)(ws + WS_W13A), *W2A = (bf16*)(ws + WS_W2A), *W13B = (bf16*)(ws + WS_W13B), *W2B = (bf16*)(ws + WS_W2B), *WIN = (bf16*)(ws + WS_WIN), *WOUT = (bf16*)(ws + WS_WOUT);
    bf16 *XN = (bf16*)(ws + WS_XN), *ACT = (bf16*)(ws + WS_ACT), *U = (bf16*)(ws + WS_U), *QKV = (bf16*)(ws + WS_QKV), *O4 = (bf16*)(ws + WS_O4), *MIX = (bf16*)(ws + WS_MIX);
    float* F = (float*)(ws + WS_F);

    { const int tid0 = wave * 64 + MK_LANE();
      for (int u = tid0; u < (LDS_BYTES - LDSCTL_OFF) / 4; u += NWAVES * 64) ((LAS unsigned*)(ldsl + LDSCTL_OFF))[u] = 0u; }
    __syncthreads();
    XcdBarrier bar; bar.bar = (unsigned*)(ctl + CW_BAR); bar.x = 0; bar.st = nullptr;
    if (N_LAUNCHES == 1) bar = xcd_barrier_post((unsigned*)(ctl + CW_BAR), MISC + 8);
#define GRID_BAR() do { if (N_LAUNCHES == 1) xcd_barrier(bar, wave * 64 + MK_LANE()); } while (0)
    const int lo = args.ph_lo, hi = args.ph_hi;
#define IN(k) (lo <= (k) && (k) < hi)
#define BOTH(k) (IN(k) && IN((k) + 1))

    if (IN(0)) {
        const int lane = MK_LANE(), tid = wave * 64 + lane;
        p0_adaln(c, w_ada, b_ada, mod, ldsl, vcu, G, tid);
        WPtrs P{args.in[6], args.in[7], args.in[8], args.in[18], args.in[19], args.in[20], args.in[9], args.in[17], args.in[10], W13A, W2A, W13B, W2B, WIN, WOUT, WPT};
        p0_convert(P, ldsl, gw, NGW, wave, lane);
        if (BOTH(0)) GRID_BAR();
    }
    if (IN(1)) { rowpass_first(x, pre_g, mod, XN, gw, NGW, MK_LANE()); if (BOTH(1)) GRID_BAR(); }
    if (IN(2)) {
        pg8::Gemm g{XN, W13A, M, 2 * DFF, DM}; pg8::StaticOrder S; S.init(M, 2 * DFF, G, bx);
        pg8::EpiSwiGLU E{ACT, DFF};
        pg8::gemm_phase<pg8::EpiSwiGLU, pg8::StaticOrder, true, true>(ldsl + RING_OFF, g, S, E, wave * 64 + MK_LANE());
        if (BOTH(2)) GRID_BAR();
    }
    if (IN(3)) {
        pg8::Gemm g{ACT, W2A, M, DM, DFF}; pg8::StaticOrder S; S.init(M, DM, G, bx);
        pg8::EpiF32 E{F, DM};
        pg8::gemm_phase<pg8::EpiF32, pg8::StaticOrder, true, true>(ldsl + RING_OFF, g, S, E, wave * 64 + MK_LANE());
        if (BOTH(3)) GRID_BAR();
    }
    if (IN(4)) { rowpass_mid(F, x, out, XN, post_g, pre_g + DM, mod, mod + 3 * DM, 0.5f, gw, NGW, MK_LANE()); if (BOTH(4)) GRID_BAR(); }
    if (IN(5)) {
        pg8::Gemm g{XN, WIN, M, DIN, DM}; pg8::StaticOrder S; S.init(M, DIN, G, bx);
        pg8::EpiProj E{U, QKV};
        pg8::gemm_phase<pg8::EpiProj, pg8::StaticOrder, true, true>(ldsl + RING_OFF, g, S, E, wave * 64 + MK_LANE());
        if (BOTH(5)) GRID_BAR();
    }
    if (IN(6)) {
        { const int lane = MK_LANE(); for (int task = gw; task < (M / 16) * 4; task += NGW) pool_task(U, WPT, pool_scale, MIX, task, lane); }
        attn_phase(QKV, O4, (char*)lds + RING_OFF, vcu, G, wave * 64 + MK_LANE());
        if (BOTH(6)) GRID_BAR();
    }
    if (IN(7)) { combine_phase(O4, subln_g, lq1, lk1, lq2, lk2, MIX, gw, NGW, MK_LANE()); if (BOTH(7)) GRID_BAR(); }
    if (IN(8)) {
        pg8::Gemm g{MIX, WOUT, M, DM, DM}; pg8::StaticOrder S; S.init(M, DM, G, bx);
        pg8::EpiF32 E{F, DM};
        pg8::gemm_phase<pg8::EpiF32, pg8::StaticOrder, true, true>(ldsl + RING_OFF, g, S, E, wave * 64 + MK_LANE());
        if (BOTH(8)) GRID_BAR();
    }
    if (IN(9)) { rowpass_mid(F, out, out, XN, post_g + DM, pre_g + 2 * DM, mod + 3 * DM, mod + 6 * DM, 1.0f, gw, NGW, MK_LANE()); if (BOTH(9)) GRID_BAR(); }
    if (IN(10)) {
        pg8::Gemm g{XN, W13B, M, 2 * DFF, DM}; pg8::StaticOrder S; S.init(M, 2 * DFF, G, bx);
        pg8::EpiSwiGLU E{ACT, DFF};
        pg8::gemm_phase<pg8::EpiSwiGLU, pg8::StaticOrder, true, true>(ldsl + RING_OFF, g, S, E, wave * 64 + MK_LANE());
        if (BOTH(10)) GRID_BAR();
    }
    if (IN(11)) {
        pg8::Gemm g{ACT, W2B, M, DM, DFF}; pg8::StaticOrder S; S.init(M, DM, G, bx);
        pg8::EpiF32 E{F, DM};
        pg8::gemm_phase<pg8::EpiF32, pg8::StaticOrder, true, true>(ldsl + RING_OFF, g, S, E, wave * 64 + MK_LANE());
        if (BOTH(11)) GRID_BAR();
    }
    if (IN(12)) { rowpass_last(F, out, out, post_g + 2 * DM, mod + 6 * DM, 0.5f, gw, NGW, MK_LANE()); }
#undef IN
#undef BOTH
#undef GRID_BAR
}

extern "C" void kernel_launch(void* const* d_in, const int* in_sizes, int n_in, void* d_out, int out_size, void* d_ws, size_t ws_size, hipStream_t stream) {
    static int grid = 0;
    if (grid == 0) {
        if (n_in != 21 || in_sizes[0] != M * DM || out_size != M * DM || ws_size < WS_END) { fprintf(stderr, "kernel_launch: unexpected shapes (n_in %d, in0 %d, out %d, ws %zu); nothing launched\n", n_in, n_in > 0 ? in_sizes[0] : -1, out_size, ws_size); grid = -1; return; }
        int dev = 0, cus = 0, per_cu = 0;
        if (hipGetDevice(&dev) != hipSuccess || hipDeviceGetAttribute(&cus, hipDeviceAttributeMultiprocessorCount, dev) != hipSuccess) { fprintf(stderr, "kernel_launch: device query failed\n"); grid = -1; return; }
        if (hipFuncSetAttribute((const void*)mk_fwd, hipFuncAttributeMaxDynamicSharedMemorySize, LDS_BYTES) != hipSuccess) { fprintf(stderr, "kernel_launch: hipFuncSetAttribute failed\n"); grid = -1; return; }
        if (hipOccupancyMaxActiveBlocksPerMultiprocessor(&per_cu, (const void*)mk_fwd, NWAVES * 64, LDS_BYTES) != hipSuccess || per_cu < 1) fprintf(stderr, "kernel_launch: note: occupancy query reports %d workgroups per CU\n", per_cu);
        (void)hipGetLastError();
        grid = cus;
    }
    if (grid < 0) return;
    if (hipMemsetAsync((char*)d_ws + WS_CTL, 0, CTL_ZERO_BYTES, stream) != hipSuccess) { fprintf(stderr, "kernel_launch: hipMemsetAsync failed\n"); return; }
    Args a{};
    for (int i = 0; i < 21; ++i) a.in[i] = (const float*)d_in[i];
    a.out = (float*)d_out; a.ws = (unsigned char*)d_ws;
    for (int li = 0; li < N_LAUNCHES; ++li) {
        a.ph_lo = (N_LAUNCHES == 1) ? 0 : li; a.ph_hi = (N_LAUNCHES == 1) ? N_PHASES : li + 1;
        hipLaunchKernelGGL(mk_fwd, dim3(grid), dim3(NWAVES * 64), LDS_BYTES, stream, a);
        const hipError_t le = hipPeekAtLastError();
        if (le != hipSuccess) { fprintf(stderr, "kernel_launch: launch %d failed: %s\n", li, hipGetErrorName(le)); break; }
    }
}
```

```cpp
#include <hip/hip_runtime.h>
#include <hip/hip_bf16.h>
#include <cstdio>
#include <cstdint>
#include <cmath>
namespace pg8 {
#define PG8_LAS __attribute__((address_space(3)))
typedef unsigned short bf16_t;
typedef short bf16x8 __attribute__((ext_vector_type(8)));
typedef float f32x4 __attribute__((ext_vector_type(4)));
typedef unsigned u32x4 __attribute__((ext_vector_type(4)));
constexpr int BM = 256, BK = 64, HALF = 128, HTB = HALF * BK * 2  , STAGE_BYTES = 8 * HTB, NXCD = 8, WGM = 8;

__host__ __device__ __forceinline__ int lds_byte(int r, int c) { const int st = (r >> 4) * 2 + (c >> 5), rr = r & 15, cc = c & 31, ob = rr * 64 + cc * 2; return st * 1024 + (ob ^ (((ob >> 9) & 1) << 5)); }
__host__ __device__ __forceinline__ void stage_rc(int b, int& R, int& C) { const int st = b / 1024, sb = b % 1024, swz = sb ^ (((sb >> 9) & 1) << 5); R = (st >> 1) * 16 + swz / 64; C = (st & 1) * 32 + (swz % 64) / 2; }
__host__ __device__ __forceinline__ int perm32(int rho) { const int n = rho >> 4, i = rho & 15; return 8 * (i >> 2) + 4 * n + (i & 3); }

struct Unit { int pm, pn; };
struct Gemm { const bf16_t* A; const bf16_t* Bt; int M, N, K; };

struct StaticOrder {
    int nM, nN, nwg, G, c, wgm;
    __host__ __device__ void init(int M, int N, int G_, int c_, int wgm_ = WGM) { nM = M / BM; nN = N / BM; nwg = nM * nN; G = G_; c = c_; wgm = wgm_; }
    __host__ __device__ bool next(int i, Unit& u) const {
        const long L = (long)i * G + c; if (L >= nwg) return false;
        int wgid = (int)L; { const int q = nwg / NXCD, r = nwg % NXCD, xcd = wgid % NXCD, off = wgid / NXCD; wgid = (xcd < r ? xcd * (q + 1) : r * (q + 1) + (xcd - r) * q) + off; }
        const int nig = wgm * nN, gid = wgid / nig, fm = gid * wgm, gsz = (nM - fm) < wgm ? (nM - fm) : wgm;
        u.pm = fm + ((wgid % nig) % gsz); u.pn = (wgid % nig) / gsz; return true;
    }
    __device__ __forceinline__ void a_ready(const Unit&) const {}
    __device__ __forceinline__ void done(const Unit&) const {}
};

__device__ __forceinline__ unsigned cvt_pk_bf16(float lo, float hi) { unsigned r; asm volatile("v_cvt_pk_bf16_f32 %0, %1, %2" : "=v"(r) : "v"(lo), "v"(hi)); return r; }
typedef float f32x2 __attribute__((ext_vector_type(2)));

struct EpiF32 {
    static constexpr bool PERM = false, AFTER_DRAIN = false;
    float* C; int ldc;
    __device__ __forceinline__ void operator()(const f32x4 (&acc)[2][2][4][2], const Unit& u, int wr, int wc, int fr, int fq) const {
        const int row0 = u.pm * BM + wr * 64 + fr, col0 = u.pn * BM + wc * 32 + 4 * fq;
#pragma unroll
        for (int ai = 0; ai < 2; ++ai)
#pragma unroll
            for (int m = 0; m < 4; ++m) { float* rowp = C + (size_t)(row0 + ai * HALF + m * 16) * ldc + col0;
#pragma unroll
                for (int bj = 0; bj < 2; ++bj)
#pragma unroll
                    for (int n = 0; n < 2; ++n) *(f32x4*)(rowp + bj * HALF + n * 16) = acc[ai][bj][m][n]; }
    }
};
struct EpiSwiGLU {
    static constexpr bool PERM = true, AFTER_DRAIN = false;
    bf16_t* O; int ldc;
    __device__ __forceinline__ void operator()(const f32x4 (&acc)[2][2][4][2], const Unit& u, int wr, int wc, int fr, int fq) const {
        const int row0 = u.pm * BM + wr * 64 + fr, col0 = u.pn * HALF + wc * 32 + 8 * fq;
#pragma unroll
        for (int ai = 0; ai < 2; ++ai)
#pragma unroll
            for (int m = 0; m < 4; ++m) {
                float o[8];
#pragma unroll
                for (int n = 0; n < 2; ++n)
#pragma unroll
                    for (int i = 0; i < 4; ++i) { const float a = acc[ai][0][m][n][i], b = acc[ai][1][m][n][i];
                        const float e = __builtin_amdgcn_exp2f(a * -1.4426950408889634f);
                        o[4 * n + i] = (a * b) * __builtin_amdgcn_rcpf(1.0f + e); }
                u32x4 w; w.x = cvt_pk_bf16(o[0], o[1]); w.y = cvt_pk_bf16(o[2], o[3]); w.z = cvt_pk_bf16(o[4], o[5]); w.w = cvt_pk_bf16(o[6], o[7]);
                *(u32x4*)(O + (size_t)(row0 + ai * HALF + m * 16) * ldc + col0) = w; }
    }
};
struct EpiProj {
    static constexpr bool PERM = true, AFTER_DRAIN = false;
    bf16_t* U; bf16_t* QKV;
    __device__ __forceinline__ void operator()(const f32x4 (&acc)[2][2][4][2], const Unit& u, int wr, int wc, int fr, int fq) const {
        const int ct = wc * 32 + 8 * fq;
        if (u.pn < 4) {
            const int row0 = u.pm * BM + wr * 64 + fr;
#pragma unroll
            for (int ai = 0; ai < 2; ++ai)
#pragma unroll
                for (int m = 0; m < 4; ++m) { bf16_t* rowp = U + (size_t)(row0 + ai * HALF + m * 16) * 1024 + u.pn * BM + ct;
#pragma unroll
                    for (int bj = 0; bj < 2; ++bj) { const f32x4 v0 = acc[ai][bj][m][0], v1 = acc[ai][bj][m][1];
                        u32x4 w; w.x = cvt_pk_bf16(v0[0], v0[1]); w.y = cvt_pk_bf16(v0[2], v0[3]); w.z = cvt_pk_bf16(v1[0], v1[1]); w.w = cvt_pk_bf16(v1[2], v1[3]);
                        *(u32x4*)(rowp + bj * HALF) = w; } }
        } else {
            const int t = u.pn - 4, which = t / 12, sl0 = (t % 12) * 2, b = u.pm >> 3, s0 = (u.pm & 7) * BM + wr * 64 + fr;
#pragma unroll
            for (int bj = 0; bj < 2; ++bj) { bf16_t* base = QKV + ((size_t)((which * 4 + b) * 24 + sl0 + bj) * 2048) * 128 + ct;
#pragma unroll
                for (int ai = 0; ai < 2; ++ai)
#pragma unroll
                    for (int m = 0; m < 4; ++m) { const f32x4 v0 = acc[ai][bj][m][0], v1 = acc[ai][bj][m][1];
                        u32x4 w; w.x = cvt_pk_bf16(v0[0], v0[1]); w.y = cvt_pk_bf16(v0[2], v0[3]); w.z = cvt_pk_bf16(v1[0], v1[1]); w.w = cvt_pk_bf16(v1[2], v1[3]);
                        *(u32x4*)(base + (size_t)(s0 + ai * HALF + m * 16) * 128) = w; } }
        }
    }
};
struct EpiBf16P {
    static constexpr bool PERM = true, AFTER_DRAIN = false;
    bf16_t* O; int ldc;
    __device__ __forceinline__ void operator()(const f32x4 (&acc)[2][2][4][2], const Unit& u, int wr, int wc, int fr, int fq) const {
        const int row0 = u.pm * BM + wr * 64 + fr, col0 = u.pn * BM + wc * 32 + 8 * fq;
#pragma unroll
        for (int ai = 0; ai < 2; ++ai)
#pragma unroll
            for (int m = 0; m < 4; ++m) { bf16_t* rowp = O + (size_t)(row0 + ai * HALF + m * 16) * ldc + col0;
#pragma unroll
                for (int bj = 0; bj < 2; ++bj) { const f32x4 v0 = acc[ai][bj][m][0], v1 = acc[ai][bj][m][1];
                    u32x4 w; w.x = cvt_pk_bf16(v0[0], v0[1]); w.y = cvt_pk_bf16(v0[2], v0[3]); w.z = cvt_pk_bf16(v1[0], v1[1]); w.w = cvt_pk_bf16(v1[2], v1[3]);
                    *(u32x4*)(rowp + bj * HALF) = w; } }
    }
};
struct EpiSwiGLU8 {
    static constexpr bool PERM = true, AFTER_DRAIN = false;
    unsigned char* O; int ldc; float scale;
    __device__ __forceinline__ void operator()(const f32x4 (&acc)[2][2][4][2], const Unit& u, int wr, int wc, int fr, int fq) const {
        const int row0 = u.pm * BM + wr * 64 + fr, col0 = u.pn * HALF + wc * 32 + 8 * fq;
#pragma unroll
        for (int ai = 0; ai < 2; ++ai)
#pragma unroll
            for (int m = 0; m < 4; ++m) {
                float o[8];
#pragma unroll
                for (int n = 0; n < 2; ++n)
#pragma unroll
                    for (int i = 0; i < 4; ++i) { const float a = acc[ai][0][m][n][i], b = acc[ai][1][m][n][i];
                        const float e = __builtin_amdgcn_exp2f(a * -1.4426950408889634f);
                        const float v = (a * b) * __builtin_amdgcn_rcpf(1.0f + e) * scale;
                        o[4 * n + i] = __builtin_amdgcn_fmed3f(v, -448.0f, 448.0f); }
                int w0 = __builtin_amdgcn_cvt_pk_fp8_f32(o[0], o[1], 0, false); w0 = __builtin_amdgcn_cvt_pk_fp8_f32(o[2], o[3], w0, true);
                int w1 = __builtin_amdgcn_cvt_pk_fp8_f32(o[4], o[5], 0, false); w1 = __builtin_amdgcn_cvt_pk_fp8_f32(o[6], o[7], w1, true);
                typedef int i32x2 __attribute__((ext_vector_type(2)));
                *(i32x2*)(O + (size_t)(row0 + ai * HALF + m * 16) * ldc + col0) = (i32x2){w0, w1}; }
    }
};
struct EpiBf16S {
    static constexpr bool PERM = true, AFTER_DRAIN = false;
    bf16_t* O; int ldc; float scale;
    __device__ __forceinline__ void operator()(const f32x4 (&acc)[2][2][4][2], const Unit& u, int wr, int wc, int fr, int fq) const {
        const int row0 = u.pm * BM + wr * 64 + fr, col0 = u.pn * BM + wc * 32 + 8 * fq;
#pragma unroll
        for (int ai = 0; ai < 2; ++ai)
#pragma unroll
            for (int m = 0; m < 4; ++m) { bf16_t* rowp = O + (size_t)(row0 + ai * HALF + m * 16) * ldc + col0;
#pragma unroll
                for (int bj = 0; bj < 2; ++bj) { const f32x4 v0 = acc[ai][bj][m][0] * scale, v1 = acc[ai][bj][m][1] * scale;
                    u32x4 w; w.x = cvt_pk_bf16(v0[0], v0[1]); w.y = cvt_pk_bf16(v0[2], v0[3]); w.z = cvt_pk_bf16(v1[0], v1[1]); w.w = cvt_pk_bf16(v1[2], v1[3]);
                    *(u32x4*)(rowp + bj * HALF) = w; } }
    }
};
struct EpiSwiGLUi8 {
    static constexpr bool PERM = true, AFTER_DRAIN = false;
    bf16_t* O; int ldc; const float* sA; const float* amax1; const float* amax3;
    __device__ __forceinline__ void operator()(const f32x4 (&acc)[2][2][4][2], const Unit& u, int wr, int wc, int fr, int fq) const {
        typedef int i32x4e __attribute__((ext_vector_type(4)));
        const int row0 = u.pm * BM + wr * 64 + fr, col0 = u.pn * HALF + wc * 32 + 8 * fq;
        f32x4 s1[2], s3[2];
#pragma unroll
        for (int n = 0; n < 2; ++n) { s1[n] = *(const f32x4*)(amax1 + col0 + 4 * n) * (1.0f / 127.0f); s3[n] = *(const f32x4*)(amax3 + col0 + 4 * n) * (1.0f / 127.0f); }
#pragma unroll
        for (int ai = 0; ai < 2; ++ai)
#pragma unroll
            for (int m = 0; m < 4; ++m) {
                const int row = row0 + ai * HALF + m * 16; const float sa = sA[row];
                float o[8];
#pragma unroll
                for (int n = 0; n < 2; ++n) { const i32x4e i1 = __builtin_bit_cast(i32x4e, acc[ai][0][m][n]), i3 = __builtin_bit_cast(i32x4e, acc[ai][1][m][n]);
#pragma unroll
                    for (int i = 0; i < 4; ++i) { const float a = (float)i1[i] * (sa * s1[n][i]), b = (float)i3[i] * (sa * s3[n][i]);
                        const float e = __builtin_amdgcn_exp2f(a * -1.4426950408889634f);
                        o[4 * n + i] = (a * b) * __builtin_amdgcn_rcpf(1.0f + e); } }
                u32x4 w; w.x = cvt_pk_bf16(o[0], o[1]); w.y = cvt_pk_bf16(o[2], o[3]); w.z = cvt_pk_bf16(o[4], o[5]); w.w = cvt_pk_bf16(o[6], o[7]);
                *(u32x4*)(O + (size_t)row * ldc + col0) = w; }
    }
};
typedef int i32x8 __attribute__((ext_vector_type(8)));
typedef int i32x4v __attribute__((ext_vector_type(4)));
__device__ __forceinline__ i32x8 pg8_cat(bf16x8 lo, bf16x8 hi) { const i32x4v a = __builtin_bit_cast(i32x4v, lo), b = __builtin_bit_cast(i32x4v, hi); return __builtin_shufflevector(a, b, 0, 1, 2, 3, 4, 5, 6, 7); }
template <class Epi, class Sched, bool ALIGN_EPI = false, bool SP2 = false, int MODE = 0, int AUXA = 0, int AUXB = 0>
__device__ __forceinline__ void gemm_phase(PG8_LAS unsigned char* lds, const Gemm g, const Sched& S, const Epi& E, const int tid_in) {
    const int tid = tid_in, wid = __builtin_amdgcn_readfirstlane(tid >> 6), lane = tid & 63, wr = wid >> 2, wc = wid & 3, fr = lane & 15, fq = lane >> 4;
    const int K = g.K, nt = MODE ? K / 128 : K / BK;
    const int sc1 = 0x7f7f7f7f;
    unsigned voffA[2], voffB[2];
#pragma unroll
    for (int i = 0; i < 2; ++i) { int R, C; stage_rc(tid * 16 + i * 8192, R, C); const int Rb = Epi::PERM ? ((R & ~31) + perm32(R & 31)) : R;
        if constexpr (MODE == 1) { const int Cs = 16 * (2 * ((C >> 3) & 3) + (C >> 5));
            voffA[i] = (unsigned)(R * K + Cs); voffB[i] = (unsigned)(Rb * K + Cs); }
        else if constexpr (MODE == 2) { voffA[i] = (unsigned)(R * K + 2 * C); voffB[i] = (unsigned)(Rb * K + 2 * C); }
        else { voffA[i] = (unsigned)(R * K + C) * 2u; voffB[i] = (unsigned)(Rb * K + C) * 2u; } }
    const size_t kstep = (size_t)(BK * 2);
    const size_t hstep = (size_t)HALF * K * (MODE ? 1 : 2);
    const size_t tstep = 2 * hstep;
    const unsigned ldsw = (unsigned)wid * 1024u;
    const int aoff = lds_byte(wr * 64 + fr, fq * 8), boff = lds_byte(wc * 32 + fr, fq * 8);
#define PG8_SA(b, h) (((b) * 2 + (h)) * HTB)
#define PG8_SB(b, h) ((4 + (b) * 2 + (h)) * HTB)
    constexpr int PG8_AUX_voffA = AUXA, PG8_AUX_voffB = AUXB;
#define PG8_STAGE(bufoff, gbase, voff) do { _Pragma("unroll") for (int _i = 0; _i < 2; ++_i) \
        __builtin_amdgcn_global_load_lds((const unsigned*)((const char*)(gbase) + (voff)[_i]), (PG8_LAS unsigned*)(lds + (bufoff) + ldsw + _i * 8192), 16, 0, PG8_AUX_##voff); } while (0)
#define PG8_LDA(dst, b, h) do { _Pragma("unroll") for (int m = 0; m < 4; ++m) _Pragma("unroll") for (int k = 0; k < 2; ++k) dst[m][k] = *(const PG8_LAS bf16x8*)(lds + PG8_SA(b, h) + aoff + m * 2048 + k * 1024); } while (0)
#define PG8_LDB(dst, b, h) do { _Pragma("unroll") for (int n = 0; n < 2; ++n) _Pragma("unroll") for (int k = 0; k < 2; ++k) dst[n][k] = *(const PG8_LAS bf16x8*)(lds + PG8_SB(b, h) + boff + n * 2048 + k * 1024); } while (0)
#define PG8_MMA(ai, bj, At, Bt) do { __builtin_amdgcn_s_setprio(1); if constexpr (MODE == 1) { _Pragma("unroll") for (int m = 0; m < 4; ++m) _Pragma("unroll") for (int n = 0; n < 2; ++n) { \
        const i32x8 a8_ = pg8_cat(Bt[n][0], Bt[n][1]), b8_ = pg8_cat(At[m][0], At[m][1]); \
        asm volatile("v_mfma_scale_f32_16x16x128_f8f6f4 %0, %1, %2, %0, %3, %3 op_sel_hi:[0,0,0]" : "+v"(acc[ai][bj][m][n]) : "v"(a8_), "v"(b8_), "v"(sc1)); } } \
        else if constexpr (MODE == 2) { _Pragma("unroll") for (int m = 0; m < 4; ++m) _Pragma("unroll") for (int n = 0; n < 2; ++n) _Pragma("unroll") for (int k = 0; k < 2; ++k) \
        acc[ai][bj][m][n] = __builtin_bit_cast(f32x4, __builtin_amdgcn_mfma_i32_16x16x64_i8(__builtin_bit_cast(i32x4v, Bt[n][k]), __builtin_bit_cast(i32x4v, At[m][k]), __builtin_bit_cast(i32x4v, acc[ai][bj][m][n]), 0, 0, 0)); } \
        else { _Pragma("unroll") for (int m = 0; m < 4; ++m) _Pragma("unroll") for (int n = 0; n < 2; ++n) _Pragma("unroll") for (int k = 0; k < 2; ++k) \
        acc[ai][bj][m][n] = __builtin_amdgcn_mfma_f32_16x16x32_bf16(Bt[n][k], At[m][k], acc[ai][bj][m][n], 0, 0, 0); } __builtin_amdgcn_s_setprio(0); } while (0)
#define PG8_WAIT_V(n) asm volatile("s_waitcnt vmcnt(" #n ")" ::: "memory")
#define PG8_WAIT_L(n) asm volatile("s_waitcnt lgkmcnt(" #n ")" ::: "memory")
#define PG8_BAR __builtin_amdgcn_s_barrier()
#define PG8_SCHED __builtin_amdgcn_sched_barrier(0)
    Unit cur, nxt; int ui = 0;
    if (!S.next(0, cur)) return;
    f32x4 acc[2][2][4][2];
#pragma unroll
    for (int a = 0; a < 2; ++a)
#pragma unroll
        for (int b = 0; b < 2; ++b)
#pragma unroll
            for (int m = 0; m < 4; ++m)
#pragma unroll
                for (int n = 0; n < 2; ++n) acc[a][b][m][n] = (f32x4){0.f, 0.f, 0.f, 0.f};
    bf16x8 At[4][2], B0[2][2], B1[2][2];
    const char* cA = (const char*)g.A + (size_t)cur.pm * tstep; const char* cB = (const char*)g.Bt + (size_t)cur.pn * tstep;
    S.a_ready(cur);
    if constexpr (SP2) {
        PG8_STAGE(PG8_SB(0, 0), cB, voffB); PG8_STAGE(PG8_SB(0, 1), cB + hstep, voffB); PG8_STAGE(PG8_SA(0, 0), cA, voffA); PG8_STAGE(PG8_SA(0, 1), cA + hstep, voffA);
        if (wr == 1) PG8_BAR;
        PG8_WAIT_V(2); PG8_BAR;
        PG8_STAGE(PG8_SB(1, 0), cB + kstep, voffB); PG8_STAGE(PG8_SA(1, 0), cA + kstep, voffA); PG8_STAGE(PG8_SB(1, 1), cB + hstep + kstep, voffB);
        PG8_WAIT_V(6); PG8_BAR;
    } else {
        PG8_STAGE(PG8_SB(0, 0), cB, voffB); PG8_STAGE(PG8_SA(0, 0), cA, voffA); PG8_STAGE(PG8_SB(0, 1), cB + hstep, voffB); PG8_STAGE(PG8_SA(0, 1), cA + hstep, voffA);
        if (wr == 1) PG8_BAR;
        PG8_WAIT_V(4); PG8_BAR;
        PG8_STAGE(PG8_SB(1, 0), cB + kstep, voffB); PG8_STAGE(PG8_SA(1, 0), cA + kstep, voffA); PG8_STAGE(PG8_SB(1, 1), cB + hstep + kstep, voffB);
        PG8_WAIT_V(6); PG8_BAR;
    }
    for (;;) {
        const bool has_next = S.next(ui + 1, nxt);
        const char* nA = has_next ? (const char*)g.A + (size_t)nxt.pm * tstep : cA; const char* nB = has_next ? (const char*)g.Bt + (size_t)nxt.pn * tstep : cB;
        for (int t = 0; t < nt; t += 2) {
            const bool last = (t == nt - 2);
            const char* a1 = cA + (size_t)(t + 1) * kstep;
            const char* a2 = last ? nA : cA + (size_t)(t + 2) * kstep; const char* b2 = last ? nB : cB + (size_t)(t + 2) * kstep;
            const char* a3 = a2 + kstep; const char* b3 = b2 + kstep;
            if (last && has_next) S.a_ready(nxt);
            if constexpr (SP2) {
            PG8_LDB(B0, 0, 0); PG8_LDB(B1, 0, 1); PG8_SCHED; PG8_LDA(At, 0, 0); PG8_STAGE(PG8_SA(1, 1), a1 + hstep, voffA);
            PG8_WAIT_V(8); PG8_WAIT_L(0); PG8_BAR; PG8_MMA(0, 0, At, B0); PG8_MMA(0, 1, At, B1); PG8_BAR; PG8_SCHED;
            PG8_LDA(At, 0, 1); PG8_STAGE(PG8_SB(0, 0), b2, voffB); PG8_STAGE(PG8_SB(0, 1), b2 + hstep, voffB); PG8_STAGE(PG8_SA(0, 0), a2, voffA);
            PG8_WAIT_V(8); PG8_WAIT_L(0); PG8_BAR; PG8_MMA(1, 0, At, B0); PG8_MMA(1, 1, At, B1); PG8_BAR; PG8_SCHED;
            PG8_LDB(B0, 1, 0); PG8_LDB(B1, 1, 1); PG8_SCHED; PG8_LDA(At, 1, 0); PG8_STAGE(PG8_SA(0, 1), a2 + hstep, voffA);
            PG8_WAIT_V(8); PG8_WAIT_L(0); PG8_BAR; PG8_MMA(0, 0, At, B0); PG8_MMA(0, 1, At, B1); PG8_BAR; PG8_SCHED;
            PG8_LDA(At, 1, 1); PG8_STAGE(PG8_SB(1, 0), b3, voffB); PG8_STAGE(PG8_SB(1, 1), b3 + hstep, voffB); PG8_STAGE(PG8_SA(1, 0), a3, voffA);
            PG8_WAIT_V(8); PG8_WAIT_L(0); PG8_BAR; PG8_MMA(1, 0, At, B0); PG8_MMA(1, 1, At, B1); PG8_BAR; PG8_SCHED;
            } else {
            PG8_LDB(B0, 0, 0); PG8_SCHED; PG8_LDA(At, 0, 0); PG8_STAGE(PG8_SA(1, 1), a1 + hstep, voffA);
            PG8_WAIT_L(8); PG8_BAR; PG8_WAIT_L(0); PG8_MMA(0, 0, At, B0); PG8_BAR; PG8_SCHED;
            PG8_LDB(B1, 0, 1); PG8_STAGE(PG8_SB(0, 0), b2, voffB);
            PG8_BAR; PG8_WAIT_L(0); PG8_MMA(0, 1, At, B1); PG8_BAR;
            PG8_LDA(At, 0, 1); PG8_STAGE(PG8_SA(0, 0), a2, voffA);
            PG8_BAR; PG8_WAIT_L(0); PG8_MMA(1, 0, At, B0); PG8_BAR; PG8_SCHED;
            PG8_STAGE(PG8_SB(0, 1), b2 + hstep, voffB);
            PG8_WAIT_V(6); PG8_BAR; PG8_MMA(1, 1, At, B1); PG8_BAR;
            PG8_LDB(B0, 1, 0); PG8_SCHED; PG8_LDA(At, 1, 0); PG8_STAGE(PG8_SA(0, 1), a2 + hstep, voffA);
            PG8_WAIT_L(8); PG8_BAR; PG8_WAIT_L(0); PG8_MMA(0, 0, At, B0); PG8_BAR; PG8_SCHED;
            PG8_LDB(B1, 1, 1); PG8_STAGE(PG8_SB(1, 0), b3, voffB);
            PG8_BAR; PG8_WAIT_L(0); PG8_MMA(0, 1, At, B1); PG8_BAR;
            PG8_LDA(At, 1, 1); PG8_STAGE(PG8_SA(1, 0), a3, voffA);
            PG8_BAR; PG8_WAIT_L(0); PG8_MMA(1, 0, At, B0); PG8_BAR; PG8_SCHED;
            PG8_STAGE(PG8_SB(1, 1), b3 + hstep, voffB);
            PG8_WAIT_V(6); PG8_BAR; PG8_MMA(1, 1, At, B1); PG8_BAR;
            }
        }
        if constexpr (ALIGN_EPI) { if (wr == 0) PG8_BAR; }
        if constexpr (MODE == 1) { asm volatile("s_nop 15\n\ts_nop 15\n\ts_nop 15" : "+v"(acc[1][1][0][0]), "+v"(acc[1][1][0][1]), "+v"(acc[1][1][1][0]), "+v"(acc[1][1][1][1]), "+v"(acc[1][1][2][0]), "+v"(acc[1][1][2][1]), "+v"(acc[1][1][3][0]), "+v"(acc[1][1][3][1])); }
        if constexpr (!Epi::AFTER_DRAIN) { E(acc, cur, wr, wc, fr, fq); S.done(cur); }
        if (!has_next) break;
#pragma unroll
        for (int a = 0; a < 2; ++a)
#pragma unroll
            for (int b = 0; b < 2; ++b)
#pragma unroll
                for (int m = 0; m < 4; ++m)
#pragma unroll
                    for (int n = 0; n < 2; ++n) acc[a][b][m][n] = (f32x4){0.f, 0.f, 0.f, 0.f};
        cur = nxt; cA = nA; cB = nB; ++ui;
        if constexpr (ALIGN_EPI) { if (wr == 1) PG8_BAR; }
    }
    PG8_WAIT_V(0);
    if constexpr (!ALIGN_EPI) { if (wr == 0) PG8_BAR; }
    PG8_BAR;
    if constexpr (Epi::AFTER_DRAIN) { E.fused(acc, cur, wr, wc, fr, fq, lds, wid, lane); S.done(cur); }
#undef PG8_SA
#undef PG8_SB
#undef PG8_STAGE
#undef PG8_LDA
#undef PG8_LDB
#undef PG8_MMA
#undef PG8_WAIT_V
#undef PG8_WAIT_L
#undef PG8_BAR
#undef PG8_SCHED
}
}

namespace attn {
constexpr int D = 128;
constexpr float THR = 8.f;
constexpr bool WSKIP = false;
constexpr float SCALE = 0.08838834764831845f;
constexpr int NW = 8, QBLK = 32, KVBLK = 64, QB = NW * QBLK;
constexpr int SHM_V = KVBLK * D * 2, SHM_K = KVBLK * D * 2;
constexpr int LDS_BYTES = 2 * SHM_V + 2 * SHM_K + NW * 64 * 4;

using bf16 = __hip_bfloat16;
typedef short bf16x8 __attribute__((ext_vector_type(8)));
typedef short s16x4 __attribute__((ext_vector_type(4)));
typedef float f32x16 __attribute__((ext_vector_type(16)));
typedef float f32x4 __attribute__((ext_vector_type(4)));
typedef unsigned u32x4 __attribute__((ext_vector_type(4)));
template <class A, class Bt> struct same_t { static constexpr bool v = false; };
template <class A> struct same_t<A, A> { static constexpr bool v = true; };

#define KSWZ(row, colB) ((row) * 256 + ((colB) ^ (((row) & 7) << 4)))
#define SBAR() __builtin_amdgcn_sched_barrier(0)
__device__ __forceinline__ int v_st(int k, int c) { const int kk = (k & ~0xC) | ((k & 4) << 1) | ((k & 8) >> 1); return ((kk >> 3) * 4 + (c >> 5)) * 512 + ((kk & 7) * 32 + (c & 31)) * 2; }
__device__ __forceinline__ int v_rd_base(int lane) { return ((lane & 3) << 3) | (((lane >> 2) & 3) << 6) | (((lane >> 4) & 1) << 5) | (((lane >> 5) & 1) << 8); }
constexpr int v_rd_off(int d0, int ks, int half) { return d0 * 512 + ks * 4096 + half * 2048; }
__device__ __forceinline__ int crow(int r, int hi) { return (r & 3) + 8 * (r >> 2) + 4 * hi; }
__device__ __forceinline__ unsigned cvtpk(float lo, float hi) {
    unsigned r; asm volatile("v_cvt_pk_bf16_f32 %0, %1, %2" : "=v"(r) : "v"(lo), "v"(hi)); return r;
}
__device__ __forceinline__ bf16x8 pack8(f32x4 a, f32x4 b) {
    u32x4 w = {cvtpk(a[0], a[1]), cvtpk(a[2], a[3]), cvtpk(b[0], b[1]), cvtpk(b[2], b[3])};
    return *reinterpret_cast<bf16x8*>(&w);
}
template <class T> __device__ __forceinline__ bf16x8 load8(const T* p) {
    if constexpr (same_t<T, float>::v) { return pack8(*(const f32x4*)p, *(const f32x4*)(p + 4)); }
    else { return *reinterpret_cast<const bf16x8*>(p); }
}
__device__ __forceinline__ void mask_tile(f32x16& p0, f32x16& p1, int dq, unsigned W) {
    const float NEG = -__builtin_inff();
#pragma unroll
    for (int r = 0; r < 16; ++r) {
        const int c = (r & 3) + 8 * (r >> 2);
        if ((unsigned)(dq - c) >= W) p0[r] = NEG;
        if ((unsigned)(dq - c - 32) >= W) p1[r] = NEG;
    }
}
__device__ __forceinline__ void partialSM(f32x16& p0, f32x16& p1, float& m_reg, float& mn, float& alpha) {
    float pmax = p0[0]; for (int r = 1; r < 16; ++r) pmax = fmaxf(pmax, p0[r]); for (int r = 0; r < 16; ++r) pmax = fmaxf(pmax, p1[r]);
    { auto rr = __builtin_amdgcn_permlane32_swap(__float_as_uint(pmax), __float_as_uint(pmax), false, false);
      pmax = fmaxf(__uint_as_float(rr[0]), __uint_as_float(rr[1])); }
    constexpr float C2 = 1.4426950408889634f * SCALE;
    if (__builtin_expect(__all((pmax - m_reg) * SCALE <= THR), 1)) { mn = m_reg; alpha = 1.f; }
    else { mn = fmaxf(m_reg, pmax); alpha = __builtin_amdgcn_exp2f((m_reg - mn) * C2); m_reg = mn; }
    const float mnL = -mn * C2;
    for (int r = 0; r < 16; ++r) p0[r] = fmaf(p0[r], C2, mnL); for (int r = 0; r < 16; ++r) p1[r] = fmaf(p1[r], C2, mnL);
    for (int r = 0; r < 16; ++r) p0[r] = __builtin_amdgcn_exp2f(p0[r]);
}
__device__ __forceinline__ void finishSM(f32x16& p0, f32x16& p1, float alpha, float& l_reg, bf16x8& pa0, bf16x8& pa1, bf16x8& pa2, bf16x8& pa3) {
    for (int r = 0; r < 16; ++r) p1[r] = __builtin_amdgcn_exp2f(p1[r]);
    float ps = 0; for (int r = 0; r < 16; ++r) ps += p0[r]; for (int r = 0; r < 16; ++r) ps += p1[r];
    { auto rr = __builtin_amdgcn_permlane32_swap(__float_as_uint(ps), __float_as_uint(ps), false, false);
      ps = __uint_as_float(rr[0]) + __uint_as_float(rr[1]); }
    l_reg = l_reg * alpha + ps;
#define PK4(P, B_, OUT) do { unsigned a0 = cvtpk(P[B_+0], P[B_+1]), a1 = cvtpk(P[B_+2], P[B_+3]);                          \
        unsigned b0 = cvtpk(P[B_+4], P[B_+5]), b1 = cvtpk(P[B_+6], P[B_+7]);                                             \
        auto r0 = __builtin_amdgcn_permlane32_swap(a0, b0, false, false); auto r1 = __builtin_amdgcn_permlane32_swap(a1, b1, false, false); \
        u32x4 w = {r0[0], r1[0], r0[1], r1[1]}; OUT = *reinterpret_cast<bf16x8*>(&w); } while (0)
    PK4(p0, 0, pa0); PK4(p0, 8, pa1); PK4(p1, 0, pa2); PK4(p1, 8, pa3);
#undef PK4
}
template <int KB, bool SK>
__device__ __forceinline__ void qkt(f32x16& p0, f32x16& p1, const char* K_lds, int r32, int hi, const bf16x8* qr, bool act) {
    if (SK && !act) { const float NEG = -__builtin_inff();
#pragma unroll
        for (int r = 0; r < 16; ++r) { p0[r] = NEG; p1[r] = NEG; } return; }
    p0 = f32x16{}; p1 = f32x16{};
    const char* kb[4];
#pragma unroll
    for (int dd = 0; dd < 4; ++dd) kb[dd] = K_lds + KB * SHM_K + KSWZ(r32, (dd * 16 + hi * 8) * 2);
#pragma unroll
    for (int d0 = 0; d0 < 8; ++d0) { const char* a = kb[d0 & 3] + (d0 >> 2) * 128;
        bf16x8 b0 = *reinterpret_cast<const bf16x8*>(a);
        bf16x8 b1 = *reinterpret_cast<const bf16x8*>(a + 32 * 256);
        p0 = __builtin_amdgcn_mfma_f32_32x32x16_bf16(b0, qr[d0], p0, 0, 0, 0);
        p1 = __builtin_amdgcn_mfma_f32_32x32x16_bf16(b1, qr[d0], p1, 0, 0, 0); }
}
template <int VB, bool SK>
__device__ __forceinline__ void pv_tile(f32x16* o, int vb0, bf16x8 pa0, bf16x8 pa1, bf16x8 pa2, bf16x8 pa3, bool act) {
    if (SK && !act) return;
#define TRRD(dst, off) asm volatile("ds_read_b64_tr_b16 %0, %1 offset:%2" : "=&v"(dst) : "v"(vb0), "i"(off) : "memory")
#define PV_D0(d0) do { s16x4 l0, l1, l2, l3, h0, h1, h2, h3; constexpr int b_ = VB * SHM_V + v_rd_off(d0, 0, 0);     \
        TRRD(l0, b_); TRRD(h0, b_ + 2048); TRRD(l1, b_ + 4096); TRRD(h1, b_ + 6144); TRRD(l2, b_ + 8192); TRRD(h2, b_ + 10240); TRRD(l3, b_ + 12288); TRRD(h3, b_ + 14336); \
        asm volatile("s_waitcnt lgkmcnt(0)" ::: "memory"); SBAR();                 \
        o[d0] = __builtin_amdgcn_mfma_f32_32x32x16_bf16(pa0, (bf16x8){l0[0], l0[1], l0[2], l0[3], h0[0], h0[1], h0[2], h0[3]}, o[d0], 0, 0, 0);   \
        o[d0] = __builtin_amdgcn_mfma_f32_32x32x16_bf16(pa1, (bf16x8){l1[0], l1[1], l1[2], l1[3], h1[0], h1[1], h1[2], h1[3]}, o[d0], 0, 0, 0);   \
        o[d0] = __builtin_amdgcn_mfma_f32_32x32x16_bf16(pa2, (bf16x8){l2[0], l2[1], l2[2], l2[3], h2[0], h2[1], h2[2], h2[3]}, o[d0], 0, 0, 0);   \
        o[d0] = __builtin_amdgcn_mfma_f32_32x32x16_bf16(pa3, (bf16x8){l3[0], l3[1], l3[2], l3[3], h3[0], h3[1], h3[2], h3[3]}, o[d0], 0, 0, 0); } while (0)
    PV_D0(0); PV_D0(1); PV_D0(2); PV_D0(3);
#undef PV_D0
#undef TRRD
}

template <class TIn, class TOut> struct BlockRef { const TIn* Q; const TIn* K; const TIn* V; TOut* O; int P0; };
template <class TIn> struct Seam {
    bf16x8 qr[8];
    bf16x8 st_v0, st_v1, st_k0, st_k1; f32x4 sf0, sf1, sf2, sf3;
    f32x4 tq[16];
};
__device__ __forceinline__ int swa_jlo(int P0, int W) { const int lowk = P0 - W + 1; return lowk > 0 ? lowk / KVBLK : 0; }
#define ROW(p, k0, rr) ((p) + (size_t)((k0) + (rr)) * D + sc)
#define VMW() asm volatile("s_waitcnt vmcnt(0)" ::: "memory")
#define VMWN(n) asm volatile("s_waitcnt vmcnt(%0)" :: "i"(n) : "memory")
#define SLOAD_H(Kp, Vp, k0) do { S.st_v0 = load8<TIn>(ROW(Vp, k0, sr)); S.st_v1 = load8<TIn>(ROW(Vp, k0, 32 + sr));              \
                         S.st_k0 = load8<TIn>(ROW(Kp, k0, sr)); S.st_k1 = load8<TIn>(ROW(Kp, k0, 32 + sr)); } while (0)
#define SWRITE_HK(bf) do { *(bf16x8*)(K_lds + (bf) * SHM_K + kws) = S.st_k0; *(bf16x8*)(K_lds + (bf) * SHM_K + kws + 32 * 256) = S.st_k1; } while (0)
#define SWRITE_HV(bf) do { *(bf16x8*)(V_lds + (bf) * SHM_V + vst0) = S.st_v0; *(bf16x8*)(V_lds + (bf) * SHM_V + vst1) = S.st_v1; } while (0)
#define SWRITE_H(bf) do { SWRITE_HV(bf); SWRITE_HK(bf); } while (0)
#define SLOAD_F(p, k0) do { S.sf0 = *(const f32x4*)ROW(p, k0, sr); S.sf1 = *(const f32x4*)(ROW(p, k0, sr) + 4);                \
                            S.sf2 = *(const f32x4*)ROW(p, k0, 32 + sr); S.sf3 = *(const f32x4*)(ROW(p, k0, 32 + sr) + 4); } while (0)
#define SWRITE_KF(bf) do { *(bf16x8*)(K_lds + (bf) * SHM_K + kws) = pack8(S.sf0, S.sf1); *(bf16x8*)(K_lds + (bf) * SHM_K + kws + 32 * 256) = pack8(S.sf2, S.sf3); } while (0)
#define SWRITE_VF(bf) do { *(bf16x8*)(V_lds + (bf) * SHM_V + vst0) = pack8(S.sf0, S.sf1); *(bf16x8*)(V_lds + (bf) * SHM_V + vst1) = pack8(S.sf2, S.sf3); } while (0)
template <class TIn, class TOut>
__device__ __forceinline__ void causal_swa_prime(const BlockRef<TIn, TOut>& cur, int W, char* lds, Seam<TIn>& S, const int tid_in) {
    constexpr bool F32 = same_t<TIn, float>::v;
    const int tid = tid_in, wid = __builtin_amdgcn_readfirstlane(tid >> 6), lane = tid & 63, r32 = lane & 31, hi = lane >> 5;
    const int sr = tid >> 4, sc = (tid & 15) * 8, kws = KSWZ(sr, sc * 2); char* K_lds = lds + 2 * SHM_V;
    const int kb0 = swa_jlo(cur.P0, W) * KVBLK;
    for (int d0 = 0; d0 < 8; ++d0) S.qr[d0] = load8<TIn>(cur.Q + (size_t)(wid * QBLK + r32) * D + d0 * 16 + hi * 8);
    if constexpr (F32) { SLOAD_F((const float*)cur.K, kb0); VMW(); SWRITE_KF(0); SBAR(); SLOAD_F((const float*)cur.V, kb0); }
    else { SLOAD_H(cur.K, cur.V, kb0); VMW(); SWRITE_HK(0); }
    __syncthreads();
}
template <class TIn, class TOut>
__device__ __forceinline__ void causal_swa_block(const BlockRef<TIn, TOut>& cur, const BlockRef<TIn, TOut>& nxt, int skv, int W, char* lds, Seam<TIn>& S, const int tid_in) {
    constexpr bool F32 = same_t<TIn, float>::v;
    const int tid = tid_in, wid = __builtin_amdgcn_readfirstlane(tid >> 6), lane = tid & 63, r32 = lane & 31, hi = lane >> 5;
    const int j_lo = swa_jlo(cur.P0, W);
    int j_hi = (cur.P0 + QB - 1) / KVBLK + 1; if (j_hi > skv / KVBLK) j_hi = skv / KVBLK;
    const int NT = j_hi - j_lo;
    const int kbn = swa_jlo(nxt.P0, W) * KVBLK;
    const int qlo = cur.P0 + wid * QBLK, qm = qlo + r32 - 4 * hi;
    char* V_lds = lds; char* K_lds = lds + 2 * SHM_V;
    float* ws = (float*)(lds + 2 * SHM_V + 2 * SHM_K) + wid * 64; float* li_l = ws, * al_l = ws + 32;
    float m_reg = -1e30f, l_reg = 0; f32x16 o[4] = {};
    const int sr = tid >> 4, sc = (tid & 15) * 8, vst0 = v_st(sr, sc), vst1 = v_st(32 + sr, sc), kws = KSWZ(sr, sc * 2);
    const int vb0 = (int)(uintptr_t)V_lds + v_rd_base(lane);
    const TIn* Kh = cur.K; const TIn* Vh = cur.V;
#define RESC(a) do { if (__any((a) < 1.f)) { if (hi == 0) al_l[r32] = (a); asm volatile("s_waitcnt lgkmcnt(0)" ::: "memory");              \
                     for (int d_ = 0; d_ < 4; ++d_) for (int r = 0; r < 16; ++r) o[d_][r] *= al_l[crow(r, hi)]; } } while (0)
#define KBASE(t) ((j_lo + (t)) * KVBLK)
#define ACT(t) (KBASE(t) <= qlo + QBLK - 1 && KBASE(t) + KVBLK - 1 >= qlo - W + 1)
#define MASKT(P0_, P1_, t) do { const int kb_ = KBASE(t); if ((!SK || ACT(t)) && (kb_ + KVBLK - 1 > qlo || kb_ <= qlo + QBLK - 1 - W)) mask_tile(P0_, P1_, qm - kb_, (unsigned)W); } while (0)
    constexpr int NQL = F32 ? 16 : 8;
    constexpr bool SK = WSKIP && !F32;
#define SEAM_K0() do { VMWN(NQL); if constexpr (F32) { SWRITE_KF(0); SBAR(); SLOAD_F((const float*)nxt.V, kbn); } else { SWRITE_HK(0); } SBAR(); } while (0)
    f32x16 pA0, pA1, pB0, pB1; float mnA, mnB, alA, alB; bf16x8 pa0, pa1, pa2, pa3;
    if constexpr (F32) { VMW(); SWRITE_VF(0); SBAR(); } else { SWRITE_HV(0); SBAR(); }
    if (NT > 1) { if constexpr (F32) SLOAD_F((const float*)Kh, KBASE(1)); else SLOAD_H(Kh, Vh, KBASE(1)); }
    SBAR(); qkt<0, SK>(pA0, pA1, K_lds, r32, hi, S.qr, ACT(0));
    if constexpr (F32) { if (NT > 1) { VMW(); SWRITE_KF(1); SBAR(); SLOAD_F((const float*)Vh, KBASE(1)); } }
    MASKT(pA0, pA1, 0); partialSM(pA0, pA1, m_reg, mnA, alA);
    if (NT > 1) { VMW(); if constexpr (F32) { SWRITE_VF(1); SBAR(); if (NT > 2) SLOAD_F((const float*)Kh, KBASE(2)); } else SWRITE_H(1); }
    __syncthreads();
#define HALF_STEP(PX0, PX1, mnX, alX, PY0, PY1, alY, t, KB, VB, SB) do {                                                      \
        SBAR(); qkt<KB, SK>(PX0, PX1, K_lds, r32, hi, S.qr, ACT(t));                                             \
        finishSM(PY0, PY1, alY, l_reg, pa0, pa1, pa2, pa3); SBAR();                                                           \
        if ((t) + 1 < NT) { if constexpr (F32) { VMW(); SWRITE_KF(SB); SBAR(); SLOAD_F((const float*)Vh, KBASE((t) + 1)); }  \
                            else { SLOAD_H(Kh, Vh, KBASE((t) + 1)); } SBAR(); }                                               \
        pv_tile<VB, SK>(o, vb0, pa0, pa1, pa2, pa3, ACT((t) - 1)); MASKT(PX0, PX1, (t)); partialSM(PX0, PX1, m_reg, mnX, alX);                                        \
        __syncthreads();                                                                                                      \
        if ((t) + 1 < NT) { VMW(); if constexpr (F32) { SWRITE_VF(SB); SBAR(); if ((t) + 2 < NT) SLOAD_F((const float*)Kh, KBASE((t) + 2)); } \
                            else { SWRITE_H(SB); } }                                                                          \
        RESC(alX); __syncthreads(); } while (0)
    for (int t = 1; t + 1 < NT; t += 2) {
        HALF_STEP(pB0, pB1, mnB, alB, pA0, pA1, alA, t, 1, 0, 0);
        HALF_STEP(pA0, pA1, mnA, alA, pB0, pB1, alB, t + 1, 0, 1, 1);
    }
    const bool even = (NT & 1) == 0;
    if (even) { SBAR(); qkt<1, SK>(pB0, pB1, K_lds, r32, hi, S.qr, ACT(NT - 1)); SBAR(); }
#define QROW(e) (nxt.Q + (size_t)(wid * QBLK + r32) * D + ((e) >> 1) * 16 + hi * 8 + ((e) & 1) * 4)
    if constexpr (F32) { SLOAD_F((const float*)nxt.K, kbn); SBAR();
#pragma unroll
        for (int e = 0; e < 8; ++e) S.tq[e] = *(const f32x4*)QROW(e); }
    else { SLOAD_H(nxt.K, nxt.V, kbn); SBAR();
#pragma unroll
        for (int d0 = 0; d0 < 8; ++d0) S.qr[d0] = load8<TIn>(nxt.Q + (size_t)(wid * QBLK + r32) * D + d0 * 16 + hi * 8); }
    SBAR();
    finishSM(pA0, pA1, alA, l_reg, pa0, pa1, pa2, pa3); SBAR();
    if constexpr (F32) {
#pragma unroll
        for (int e = 8; e < 16; ++e) S.tq[e] = *(const f32x4*)QROW(e); SBAR(); }
#undef QROW
    pv_tile<0, SK>(o, vb0, pa0, pa1, pa2, pa3, ACT(even ? NT - 2 : NT - 1));
    if (even) { MASKT(pB0, pB1, NT - 1); partialSM(pB0, pB1, m_reg, mnB, alB); __syncthreads(); RESC(alB);
        finishSM(pB0, pB1, alB, l_reg, pa0, pa1, pa2, pa3); SBAR(); pv_tile<1, SK>(o, vb0, pa0, pa1, pa2, pa3, ACT(NT - 1)); }
    SBAR(); SEAM_K0();
    if (hi == 0) li_l[r32] = l_reg; asm volatile("s_waitcnt lgkmcnt(0)" ::: "memory");
    float rli[16];
#pragma unroll
    for (int r = 0; r < 16; ++r) rli[r] = __builtin_amdgcn_rcpf(li_l[crow(r, hi)]);
    TOut* Ow = cur.O + (size_t)(wid * QBLK) * D;
#pragma unroll
    for (int r = 0; r < 16; ++r) { const int orow = crow(r, hi);
#pragma unroll
        for (int d0 = 0; d0 < 4; ++d0) { const float v = o[d0][r] * rli[r];
            if constexpr (same_t<TOut, float>::v) { Ow[(size_t)orow * D + d0 * 32 + r32] = v; }
            else { const float vn = __shfl_xor(v, 1);
                   if ((r32 & 1) == 0) *(unsigned*)(Ow + (size_t)orow * D + d0 * 32 + r32) = cvtpk(v, vn); } } }
    if constexpr (F32) {
#pragma unroll
        for (int d0 = 0; d0 < 8; ++d0) S.qr[d0] = pack8(S.tq[2 * d0], S.tq[2 * d0 + 1]); }
    __syncthreads();
#undef RESC
#undef KBASE
#undef ACT
#undef MASKT
#undef SEAM_K0
#undef HALF_STEP
}
#undef ROW
#undef VMW
#undef VMWN
#undef SLOAD_H
#undef SWRITE_HK
#undef SWRITE_HV
#undef SWRITE_H
#undef SLOAD_F
#undef SWRITE_KF
#undef SWRITE_VF
}

namespace attx {
typedef short bf16x8 __attribute__((ext_vector_type(8)));
typedef short s16x4 __attribute__((ext_vector_type(4)));
typedef float f32x4 __attribute__((ext_vector_type(4)));
typedef unsigned u32x2 __attribute__((ext_vector_type(2)));
typedef unsigned u32x4 __attribute__((ext_vector_type(4)));
#define AX_LAS __attribute__((address_space(3)))
constexpr int SEQ = 2048, STAGE_BYTES = 49152, LDS_BYTES = 2 * STAGE_BYTES;
constexpr float C2 = 1.4426950408889634f * 0.08838834764831845f;
constexpr float THR = 8.0f;
__device__ __forceinline__ unsigned cvtpk(float lo, float hi) { unsigned r; asm volatile("v_cvt_pk_bf16_f32 %0, %1, %2" : "=v"(r) : "v"(lo), "v"(hi)); return r; }
struct Block { const unsigned short* Q; const unsigned short* K; const unsigned short* V0; const unsigned short* V1; unsigned short* O; int qb; };
__device__ __forceinline__ void dma_offsets(int (&doff)[2], int wave, int lane) {
    const int rin = lane >> 4, chs = lane & 15;
#pragma unroll
    for (int i = 0; i < 2; ++i) { const int row = 4 * (i * 8 + wave) + rin; doff[i] = 256 * row + 16 * (chs ^ (((row & 3) << 2) | ((row >> 2) & 3))); }
}
__device__ __forceinline__ void dma_tile(const unsigned short* pK, const unsigned short* pV0, const unsigned short* pV1, const int (&doff)[2], int t, int st, AX_LAS unsigned char* lds, int wave) {
#pragma unroll
    for (int i = 0; i < 6; ++i) {
        const unsigned short* base = i < 2 ? pK : (i < 4 ? pV0 : pV1);
        const char* src = (const char*)base + (size_t)t * 16384 + (unsigned)doff[i & 1];
        __builtin_amdgcn_global_load_lds((const unsigned*)src, (AX_LAS unsigned*)(lds + st * STAGE_BYTES + (i * 8 + wave) * 1024), 16, 0, 0);
    }
}
__device__ __forceinline__ void attn_block(const Block& B, AX_LAS unsigned char* lds, int wave, int lane) {
    const int qi = lane & 15, g = lane >> 4, q0 = B.qb * 256 + 32 * wave;
    const int NT = 4 * (B.qb + 1);
    const unsigned short* pK = B.K; const unsigned short* pV0 = B.V0; const unsigned short* pV1 = B.V1;
    int doff[2]; dma_offsets(doff, wave, lane);
    dma_tile(pK, pV0, pV1, doff, 0, 0, lds, wave);
    bf16x8 qf[2][4];
#pragma unroll
    for (int rb = 0; rb < 2; ++rb)
#pragma unroll
        for (int s = 0; s < 4; ++s) qf[rb][s] = *(const bf16x8*)(B.Q + (size_t)(q0 + 16 * rb + qi) * 128 + 32 * s + 8 * g);
    f32x4 o[2][16];
#pragma unroll
    for (int rb = 0; rb < 2; ++rb)
#pragma unroll
        for (int cb = 0; cb < 16; ++cb) o[rb][cb] = (f32x4){0.f, 0.f, 0.f, 0.f};
    float mref[2] = {-1e30f, -1e30f}, lsum[2] = {0.f, 0.f};
    const int mk = ((qi & 3) << 2) | ((qi >> 2) & 3), mk2 = mk >> 2, kbase_l = 256 * qi + 16 * (g ^ (mk & 3));
    const int mv = ((qi >> 2) << 2) | g, mv3 = mv >> 1, vbase_l = 16384 + 256 * (4 * g + (qi >> 2)) + 16 * (((qi & 3) >> 1) ^ (mv & 1)) + 8 * (qi & 1);
    for (int t = 0; t < NT; ++t) {
        asm volatile("s_waitcnt vmcnt(0)" ::: "memory");
        __builtin_amdgcn_s_barrier();
        asm volatile("" ::: "memory");
        if (t + 1 < NT) dma_tile(pK, pV0, pV1, doff, t + 1, (t + 1) & 1, lds, wave);
        if (64 * t > q0 + 31) continue;
        const AX_LAS unsigned char* stg = lds + (t & 1) * STAGE_BYTES;
        f32x4 sc[2][4];
#pragma unroll
        for (int kb = 0; kb < 4; ++kb) {
            sc[0][kb] = (f32x4){0.f, 0.f, 0.f, 0.f}; sc[1][kb] = (f32x4){0.f, 0.f, 0.f, 0.f};
#pragma unroll
            for (int s = 0; s < 4; ++s) { const bf16x8 kf = *(const AX_LAS bf16x8*)(stg + 4096 * kb + kbase_l + 64 * (s ^ mk2));
                sc[0][kb] = __builtin_amdgcn_mfma_f32_16x16x32_bf16(kf, qf[0][s], sc[0][kb], 0, 0, 0);
                sc[1][kb] = __builtin_amdgcn_mfma_f32_16x16x32_bf16(kf, qf[1][s], sc[1][kb], 0, 0, 0); } }
        if (64 * t + 63 > q0) {
#pragma unroll
            for (int rb = 0; rb < 2; ++rb) { const int qpos = q0 + 16 * rb + qi;
#pragma unroll
                for (int kb = 0; kb < 4; ++kb)
#pragma unroll
                    for (int r = 0; r < 4; ++r) if (64 * t + 16 * kb + 4 * g + r > qpos) sc[rb][kb][r] = -__builtin_inff(); } }
        float pm[2];
#pragma unroll
        for (int rb = 0; rb < 2; ++rb) { float m = fmaxf(fmaxf(sc[rb][0][0], sc[rb][0][1]), fmaxf(sc[rb][0][2], sc[rb][0][3]));
#pragma unroll
            for (int kb = 1; kb < 4; ++kb) m = fmaxf(m, fmaxf(fmaxf(sc[rb][kb][0], sc[rb][kb][1]), fmaxf(sc[rb][kb][2], sc[rb][kb][3])));
            m = fmaxf(m, __shfl_xor(m, 16)); m = fmaxf(m, __shfl_xor(m, 32)); pm[rb] = m; }
        if (!__all((pm[0] - mref[0]) * C2 <= THR && (pm[1] - mref[1]) * C2 <= THR)) {
#pragma unroll
            for (int rb = 0; rb < 2; ++rb) { const float mn = fmaxf(mref[rb], pm[rb]), al = __builtin_amdgcn_exp2f((mref[rb] - mn) * C2); mref[rb] = mn; lsum[rb] *= al;
#pragma unroll
                for (int cb = 0; cb < 16; ++cb) o[rb][cb] = o[rb][cb] * al; } }
        u32x4 pf[2][2];
#pragma unroll
        for (int rb = 0; rb < 2; ++rb) { const float mb = -mref[rb] * C2; float ps = 0.f;
#pragma unroll
            for (int kb = 0; kb < 4; ++kb)
#pragma unroll
                for (int r = 0; r < 4; ++r) { const float p = __builtin_amdgcn_exp2f(fmaf(sc[rb][kb][r], C2, mb)); sc[rb][kb][r] = p; ps += p; }
            lsum[rb] += ps;
#pragma unroll
            for (int ks = 0; ks < 2; ++ks) pf[rb][ks] = (u32x4){cvtpk(sc[rb][2 * ks][0], sc[rb][2 * ks][1]), cvtpk(sc[rb][2 * ks][2], sc[rb][2 * ks][3]), cvtpk(sc[rb][2 * ks + 1][0], sc[rb][2 * ks + 1][1]), cvtpk(sc[rb][2 * ks + 1][2], sc[rb][2 * ks + 1][3])}; }
        const int sbase = (int)(unsigned)(unsigned long long)(stg);
#pragma unroll
        for (int ks = 0; ks < 2; ++ks)
#pragma unroll
            for (int hv = 0; hv < 2; ++hv) {
#pragma unroll
                for (int cq = 0; cq < 2; ++cq) {
                    s16x4 v0[4], v1[4];
#pragma unroll
                    for (int c = 0; c < 4; ++c) { const int a = sbase + vbase_l + 32 * ((4 * cq + c) ^ mv3);
                        asm volatile("ds_read_b64_tr_b16 %0, %1 offset:%2" : "=&v"(v0[c]) : "v"(a), "i"(16384 * hv + 4096 * (2 * ks)) : "memory");
                        asm volatile("ds_read_b64_tr_b16 %0, %1 offset:%2" : "=&v"(v1[c]) : "v"(a), "i"(16384 * hv + 4096 * (2 * ks + 1)) : "memory"); }
                    asm volatile("s_waitcnt lgkmcnt(0)" ::: "memory"); __builtin_amdgcn_sched_barrier(0);
#pragma unroll
                    for (int c = 0; c < 4; ++c) { const bf16x8 vf = (bf16x8){v0[c][0], v0[c][1], v0[c][2], v0[c][3], v1[c][0], v1[c][1], v1[c][2], v1[c][3]};
                        o[0][8 * hv + 4 * cq + c] = __builtin_amdgcn_mfma_f32_16x16x32_bf16(vf, __builtin_bit_cast(bf16x8, pf[0][ks]), o[0][8 * hv + 4 * cq + c], 0, 0, 0);
                        o[1][8 * hv + 4 * cq + c] = __builtin_amdgcn_mfma_f32_16x16x32_bf16(vf, __builtin_bit_cast(bf16x8, pf[1][ks]), o[1][8 * hv + 4 * cq + c], 0, 0, 0); }
                }
            }
    }
#pragma unroll
    for (int rb = 0; rb < 2; ++rb) { float l = lsum[rb]; l += __shfl_xor(l, 16); l += __shfl_xor(l, 32); const float il = 1.0f / l;
        unsigned short* orow = B.O + (size_t)(q0 + 16 * rb + qi) * 256 + 4 * g;
#pragma unroll
        for (int cb = 0; cb < 16; ++cb) { const f32x4 v = o[rb][cb] * il; *(u32x2*)(orow + 16 * cb) = (u32x2){cvtpk(v[0], v[1]), cvtpk(v[2], v[3])}; } }
}
}
#define GAS __attribute__((address_space(1)))
#define LAS __attribute__((address_space(3)))
typedef unsigned short bf16;
typedef unsigned v4u __attribute__((ext_vector_type(4)));
typedef float f32x4 __attribute__((ext_vector_type(4)));
typedef short bf16x8 __attribute__((ext_vector_type(8)));
typedef GAS unsigned gu32;
typedef GAS unsigned long long gu64;
#define RLX_AGENT __ATOMIC_RELAXED, __HIP_MEMORY_SCOPE_AGENT
#define LDS_WAIT() asm volatile("s_waitcnt lgkmcnt(0)" ::: "memory")
#define VM_WAIT() asm volatile("s_waitcnt vmcnt(0)" ::: "memory")
__device__ __forceinline__ unsigned long long rt() { return __builtin_amdgcn_s_memrealtime(); }
__device__ __forceinline__ unsigned f2bf(float f) { unsigned u = __builtin_bit_cast(unsigned, f); return (u + 0x7fffu + ((u >> 16) & 1u)) >> 16; }
__device__ __forceinline__ unsigned pk2(float lo, float hi) { return f2bf(lo) | (f2bf(hi) << 16); }

#define XB_TMO      128
#define XB_XCNT(j)  (256  + 64 * (j))
#define XB_XSUB(j)  (1280 + 64 * (j))
#define XB_XGEN(j)  (2304 + 64 * (j))
#define XB_TOP      3328
#define XB_TOPGEN   3392
#define XCD_BAR_WORDS 3456
#define XB_SPIN_CAP (1u << 18)

__device__ __forceinline__ unsigned xb_ld(unsigned* p)              { return __hip_atomic_load(p, __ATOMIC_RELAXED, __HIP_MEMORY_SCOPE_AGENT); }
__device__ __forceinline__ unsigned xb_add(unsigned* p, unsigned v) { return __hip_atomic_fetch_add(p, v, __ATOMIC_RELAXED, __HIP_MEMORY_SCOPE_AGENT); }
__device__ __forceinline__ unsigned xb_xcc_id() { return (unsigned)__builtin_amdgcn_s_getreg((3 << 11) | 20) & 0xFu; }
#define XB_SPIN(cond, bar) do { unsigned _sp = 0; while (cond) { __builtin_amdgcn_s_sleep(1); \
    if ((++_sp & 255u) == 0u) { if (xb_ld(&(bar)[XB_TMO])) break; if (_sp > XB_SPIN_CAP) { atomicAdd(&(bar)[XB_TMO], 1u); break; } } } } while (0)

struct XcdBarrier {
    unsigned* bar; unsigned x;
    volatile LAS unsigned* st;
};

__device__ __forceinline__ XcdBarrier xcd_barrier_post(unsigned* bar, volatile LAS unsigned* st) {
    XcdBarrier b; b.bar = bar; b.x = xb_xcc_id(); b.st = st;
    if (threadIdx.x == 0) (void)xb_add(&bar[XB_XCNT(b.x)], 1u);
    return b;
}
__device__ __forceinline__ void xcd_barrier_complete(unsigned* bar, unsigned x, unsigned& nloc, unsigned& nx) {
    const unsigned G = gridDim.x * gridDim.y * gridDim.z;
    unsigned sum, cnt, mine, sp = 0u;
    for (;;) {
        sum = 0u; cnt = 0u; mine = 0u;
#pragma unroll
        for (unsigned j = 0; j < 16; ++j) { const unsigned c = xb_ld(&bar[XB_XCNT(j)]); sum += c; cnt += (c > 0u) ? 1u : 0u; mine = (j == x) ? c : mine; }
        if (sum == G) break;
        __builtin_amdgcn_s_sleep(1);
        if ((++sp & 255u) == 0u) { if (xb_ld(&bar[XB_TMO])) break; if (sp > XB_SPIN_CAP) { atomicAdd(&bar[XB_TMO], 1u); break; } }
    }
    nloc = mine > 0u ? mine : 1u; nx = cnt > 0u ? cnt : 1u;
}

__device__ __forceinline__ void xcd_barrier(const XcdBarrier& b, const int tid_in) {
    asm volatile("s_waitcnt vmcnt(0)" ::: "memory");
    __syncthreads();
    if (tid_in == 0) {
        unsigned* bar = b.bar;
        __builtin_amdgcn_s_waitcnt(0);
        unsigned nloc = b.st[0], nx = b.st[1];
        if (nloc == 0u) { xcd_barrier_complete(bar, b.x, nloc, nx); b.st[0] = nloc; b.st[1] = nx; }
        const unsigned old = xb_add(&bar[XB_XSUB(b.x)], 1u);
        const unsigned gen = old / nloc;
        if (old + 1u == (gen + 1u) * nloc) {
            __builtin_amdgcn_fence(__ATOMIC_RELEASE, "agent");
            asm volatile("s_waitcnt vmcnt(0)" ::: "memory");
            const unsigned og = xb_add(&bar[XB_TOP], 1u);
            const unsigned tg = og / nx;
            if (og + 1u == (tg + 1u) * nx) xb_add(&bar[XB_TOPGEN], 1u);
            else XB_SPIN(xb_ld(&bar[XB_TOPGEN]) == tg, bar);
            __builtin_amdgcn_fence(__ATOMIC_ACQUIRE, "agent");
            xb_add(&bar[XB_XGEN(b.x)], 1u);
            asm volatile("s_waitcnt vmcnt(0)" ::: "memory");
        } else {
            XB_SPIN(xb_ld(&bar[XB_XGEN(b.x)]) == gen, bar);
            __builtin_amdgcn_fence(__ATOMIC_ACQUIRE, "agent");
            asm volatile("s_waitcnt vmcnt(0)" ::: "memory");
        }
    }
    __syncthreads();
}

constexpr int NWAVES = 8;
#ifndef MK_N_LAUNCHES
#define MK_N_LAUNCHES 1
#endif
constexpr int N_PHASES = 13;
#ifndef CV_SPLIT
#define CV_SPLIT 1
#endif
constexpr int N_LAUNCHES = MK_N_LAUNCHES;
static_assert(N_LAUNCHES == 1 || N_LAUNCHES == N_PHASES, "MK_N_LAUNCHES is 1 or 13");
constexpr int NB = 4, SEQ = 2048, DM = 4096, M = NB * SEQ, DFF = 11008, DPOOL = 1024, NH = 12, DIN = 10240, NMOD = 9 * DM;
constexpr float EPS = 1e-6f;
#ifndef FFN2_DOWN_FP8
#define FFN2_DOWN_FP8 0
#endif
#ifndef FFN_UP_INT8
#define FFN_UP_INT8 1
#endif
#ifndef UP_WGM
#define UP_WGM 4
#endif
#ifndef DOWN_AUXA
#define DOWN_AUXA 0
#endif
#ifndef DOWN_AUXB
#define DOWN_AUXB 0
#endif
#ifndef ATTN_V2
#define ATTN_V2 1
#endif
#ifndef W2_IDLE_PCT
#define W2_IDLE_PCT 55
#endif
constexpr float F8_SA = 4.0f, F8_SW = 2048.0f;
constexpr float ONE_MINUS_LAMBDA_INIT = 0.8f, LAMBDA_INIT = 0.2f;

constexpr size_t MiB = 1u << 20;
constexpr size_t WS_CTL = 0, CTL_ZERO_BYTES = 1 * MiB;
constexpr size_t WS_MOD = 1 * MiB;
constexpr size_t WS_WPT = 2 * MiB;
constexpr size_t WS_W13A = 4 * MiB, WS_W2A = 176 * MiB, WS_W13B = 262 * MiB, WS_W2B = 434 * MiB, WS_WIN = 520 * MiB, WS_WOUT = 600 * MiB;
constexpr size_t WS_XN = 632 * MiB;
constexpr size_t WS_ACT = 696 * MiB;
constexpr size_t WS_F = 868 * MiB;
constexpr size_t WS_U = 996 * MiB;
constexpr size_t WS_QKV = 1012 * MiB;
constexpr size_t WS_O4 = 1156 * MiB;
constexpr size_t WS_MIX = 1252 * MiB;
constexpr size_t WS_XR = 1316 * MiB;
constexpr size_t WS_END = 1380 * MiB;
static_assert(WS_W13A + (size_t)2 * DFF * DM * 2 <= WS_W2A && WS_W2A + (size_t)DFF * DM * 2 <= WS_W13B && WS_W13B + (size_t)2 * DFF * DM * 2 <= WS_W2B && WS_W2B + (size_t)DFF * DM * 2 <= WS_WIN, "ws map 1");
static_assert(WS_WIN + (size_t)DIN * DM * 2 <= WS_WOUT && WS_WOUT + (size_t)DM * DM * 2 <= WS_XN && WS_XN + (size_t)M * DM * 2 <= WS_ACT && WS_ACT + (size_t)M * DFF * 2 <= WS_F && WS_F + (size_t)M * DM * 4 <= WS_U, "ws map 2");
static_assert(WS_U + (size_t)M * DPOOL * 2 <= WS_QKV && WS_QKV + (size_t)3 * M * 3072 * 2 <= WS_O4 && WS_O4 + (size_t)M * 6144 * 2 <= WS_MIX && WS_MIX + (size_t)M * DM * 2 <= WS_END, "ws map 3");
constexpr int CW_BAR = 4096;
constexpr int CW_AMAX = 32768;
constexpr size_t WS_RS = 1 * MiB + 768 * 1024;
static_assert((CW_AMAX + 4 * DFF) * 4 <= (int)CTL_ZERO_BYTES && (size_t)NB * NMOD * 4 <= 768 * 1024, "ctl / mod map");

constexpr int RING_OFF = 0, RING_BYTES = 131072;
constexpr int LDSCTL_OFF = RING_BYTES, MISC_OFF = LDSCTL_OFF + 320;
constexpr int LDS_BYTES = 147456;
static_assert(MISC_OFF + 128 <= LDS_BYTES, "LDS map");

__device__ __forceinline__ float wave_sum(float v) {
#pragma unroll
    for (int o = 1; o < 64; o <<= 1) v += __shfl_xor(v, o);
    return v;
}
__device__ __forceinline__ float wave_max(float v) {
#pragma unroll
    for (int o = 1; o < 64; o <<= 1) v = fmaxf(v, __shfl_xor(v, o));
    return v;
}
__device__ __forceinline__ float bf_lo(unsigned w) { return __uint_as_float(w << 16); }
__device__ __forceinline__ float bf_hi(unsigned w) { return __uint_as_float(w & 0xffff0000u); }

__device__ __forceinline__ __amdgpu_buffer_rsrc_t mkrsrc(const void* p, unsigned bytes) {
    const unsigned long long a = (unsigned long long)p;
    const unsigned lo = __builtin_amdgcn_readfirstlane((unsigned)a), hi = __builtin_amdgcn_readfirstlane((unsigned)(a >> 32));
    return __builtin_amdgcn_make_buffer_rsrc((void*)(((unsigned long long)hi << 32) | lo), 0, bytes, 0x00020000);
}
__device__ __forceinline__ void p0_adaln(const float* c, const float* w_ada, const float* b_ada, float* mod, LAS unsigned char* lds, int wg, int G, int tid) {
    LAS float* sil = (LAS float*)lds;
    LAS float* red = (LAS float*)(lds + 65536);
    for (int i = tid; i < NB * DM; i += NWAVES * 64) { const int b = i / DM, k = i % DM; const float v = c[i]; sil[k * 4 + b] = v / (1.f + __expf(-v)); }
    __syncthreads();
    const int wave = tid >> 6, lane = tid & 63;
    for (int ch = wg; ch < 256; ch += G) {
        const int j0 = ch * 144;
        if (lane < 36) {
            f32x4 a0 = {0.f, 0.f, 0.f, 0.f}, a1 = a0, a2 = a0, a3 = a0;
            const float* wp = w_ada + (size_t)(wave * 512) * NMOD + j0 + 4 * lane;
            const LAS float* sp = sil + wave * 512 * 4;
            for (int k = 0; k < 512; k += 16) {
                f32x4 w[16];
#pragma unroll
                for (int u = 0; u < 16; ++u) w[u] = __builtin_nontemporal_load((const GAS f32x4*)(wp + (size_t)(k + u) * NMOD));
#pragma unroll
                for (int u = 0; u < 16; ++u) { const f32x4 s = *(const LAS f32x4*)(sp + (k + u) * 4); a0 += w[u] * s.x; a1 += w[u] * s.y; a2 += w[u] * s.z; a3 += w[u] * s.w; }
            }
            LAS float* r = red + wave * 576 + 4 * lane;
            *(LAS f32x4*)(r) = a0; *(LAS f32x4*)(r + 144) = a1; *(LAS f32x4*)(r + 288) = a2; *(LAS f32x4*)(r + 432) = a3;
        }
        __syncthreads();
        for (int o = tid; o < 576; o += NWAVES * 64) { const int b = o / 144, col = o % 144; float s = 0.f;
#pragma unroll
            for (int w = 0; w < 8; ++w) s += red[w * 576 + o];
            mod[b * NMOD + j0 + col] = s + b_ada[j0 + col]; }
        __syncthreads();
    }
}
typedef unsigned v2u __attribute__((ext_vector_type(2)));
constexpr int CV_TP = 68, CV_TILE_BYTES = 64 * CV_TP * 2;
struct CvMat { const float* W; bf16* WT; int K, N, mode; };
__device__ __forceinline__ void cv_load(const CvMat& m, int item, int lane, f32x4 (&v)[16]) {
    const int nblk = m.N / 64, kb = item / nblk, nb = item % nblk;
    const float* src = m.W + (size_t)(64 * kb + (lane >> 4)) * m.N + 64 * nb + 4 * (lane & 15);
#pragma unroll
    for (int i = 0; i < 16; ++i) v[i] = __builtin_nontemporal_load((const GAS f32x4*)(src + (size_t)(4 * i) * m.N));
}
__device__ __forceinline__ void cv_matrix(const CvMat& m, LAS unsigned short* T, int first, int stride, int lane, int it_lo = 0, int it_hi = 0x7fffffff) {
    const int nblk = m.N / 64, ntot = (m.K / 64) * nblk, nitems = it_hi < ntot ? it_hi : ntot;
    first += it_lo;
    if (first >= nitems) return;
    f32x4 v[16];
    cv_load(m, first, lane, v);
    for (int it = first; it < nitems; it += stride) {
        { const int kq = lane >> 4, nq = 4 * (lane & 15);
#pragma unroll
          for (int i = 0; i < 16; ++i) { v2u w; w.x = pk2(v[i].x, v[i].y); w.y = pk2(v[i].z, v[i].w); *(LAS v2u*)(T + (4 * i + kq) * CV_TP + nq) = w; } }
        LDS_WAIT(); asm volatile("" ::: "memory");
        if (it + stride < nitems) cv_load(m, it + stride, lane, v);
        const int kb = it / nblk, nb = it % nblk, k0 = 64 * kb, n0 = 64 * nb;
        const int orow0 = m.mode == 0 ? n0 : (256 * (n0 >> 7) + (n0 & 127) + 128 * (m.mode - 1));
        const int c = lane & 7, nl = lane >> 3;
#pragma unroll
        for (int p = 0; p < 8; ++p) { const int n = 8 * p + nl; const LAS unsigned short* s = T + (8 * c) * CV_TP + n;
            v4u o; o.x = (unsigned)s[0] | ((unsigned)s[CV_TP] << 16); o.y = (unsigned)s[2 * CV_TP] | ((unsigned)s[3 * CV_TP] << 16);
            o.z = (unsigned)s[4 * CV_TP] | ((unsigned)s[5 * CV_TP] << 16); o.w = (unsigned)s[6 * CV_TP] | ((unsigned)s[7 * CV_TP] << 16);
            *(GAS v4u*)(m.WT + (size_t)(orow0 + n) * m.K + k0 + 8 * c) = o; }
        LDS_WAIT(); asm volatile("" ::: "memory");
    }
}
__device__ __forceinline__ void cv8_matrix(const float* W, int K, int N, unsigned char* WT, float scale, LAS unsigned char* T, int first, int stride, int lane) {
    const int nblk = N / 64, nitems = (K / 64) * nblk;
    if (first >= nitems) return;
    CvMat m; m.W = W; m.WT = nullptr; m.K = K; m.N = N; m.mode = 0;
    f32x4 v[16];
    cv_load(m, first, lane, v);
    for (int it = first; it < nitems; it += stride) {
        { const int kq = lane >> 4, nq = 4 * (lane & 15);
#pragma unroll
          for (int i = 0; i < 16; ++i) { const f32x4 s = v[i] * scale;
              int w = __builtin_amdgcn_cvt_pk_fp8_f32(__builtin_amdgcn_fmed3f(s.x, -448.f, 448.f), __builtin_amdgcn_fmed3f(s.y, -448.f, 448.f), 0, false);
              w = __builtin_amdgcn_cvt_pk_fp8_f32(__builtin_amdgcn_fmed3f(s.z, -448.f, 448.f), __builtin_amdgcn_fmed3f(s.w, -448.f, 448.f), w, true);
              *(LAS int*)(T + (4 * i + kq) * 68 + nq) = w; } }
        LDS_WAIT(); asm volatile("" ::: "memory");
        if (it + stride < nitems) cv_load(m, it + stride, lane, v);
        const int kb = it / nblk, nb = it % nblk, k0 = 64 * kb, n0 = 64 * nb;
        const int c = lane & 3, nl = lane >> 2;
#pragma unroll
        for (int p = 0; p < 4; ++p) { const int n = 16 * p + nl; const LAS unsigned char* s = T + (16 * c) * 68 + n;
            v4u o;
            o.x = (unsigned)s[0 * 68] | ((unsigned)s[1 * 68] << 8) | ((unsigned)s[2 * 68] << 16) | ((unsigned)s[3 * 68] << 24);
            o.y = (unsigned)s[4 * 68] | ((unsigned)s[5 * 68] << 8) | ((unsigned)s[6 * 68] << 16) | ((unsigned)s[7 * 68] << 24);
            o.z = (unsigned)s[8 * 68] | ((unsigned)s[9 * 68] << 8) | ((unsigned)s[10 * 68] << 16) | ((unsigned)s[11 * 68] << 24);
            o.w = (unsigned)s[12 * 68] | ((unsigned)s[13 * 68] << 8) | ((unsigned)s[14 * 68] << 16) | ((unsigned)s[15 * 68] << 24);
            *(GAS v4u*)(WT + (size_t)(n0 + n) * K + k0 + 16 * c) = o; }
        LDS_WAIT(); asm volatile("" ::: "memory");
    }
}
__device__ __forceinline__ void amax_pass(const float* W, int K, int N, gu32* amax, int first, int stride, int lane) {
    const int ncg = N / 256, nitems = (K / 256) * ncg;
    for (int it = first; it < nitems; it += stride) {
        const int kb = it / ncg, cg = it % ncg;
        const float* src = W + (size_t)(256 * kb) * N + 256 * cg + 4 * lane;
        f32x4 mx = {0.f, 0.f, 0.f, 0.f};
#pragma unroll 1
        for (int k = 0; k < 256; k += 16) {
            f32x4 v[16];
#pragma unroll
            for (int u = 0; u < 16; ++u) v[u] = *(const GAS f32x4*)(src + (size_t)(k + u) * N);
#pragma unroll
            for (int u = 0; u < 16; ++u) { mx.x = fmaxf(mx.x, fabsf(v[u].x)); mx.y = fmaxf(mx.y, fabsf(v[u].y)); mx.z = fmaxf(mx.z, fabsf(v[u].z)); mx.w = fmaxf(mx.w, fabsf(v[u].w)); }
        }
        gu32* d = amax + 256 * cg + 4 * lane;
        __hip_atomic_fetch_max(d + 0, __float_as_uint(mx.x), RLX_AGENT); __hip_atomic_fetch_max(d + 1, __float_as_uint(mx.y), RLX_AGENT);
        __hip_atomic_fetch_max(d + 2, __float_as_uint(mx.z), RLX_AGENT); __hip_atomic_fetch_max(d + 3, __float_as_uint(mx.w), RLX_AGENT);
    }
}
__device__ __forceinline__ unsigned q8pack(f32x4 s) {
    const int a = (int)__builtin_rintf(s.x), b = (int)__builtin_rintf(s.y), c = (int)__builtin_rintf(s.z), d = (int)__builtin_rintf(s.w);
    return ((unsigned)a & 255u) | (((unsigned)b & 255u) << 8) | (((unsigned)c & 255u) << 16) | ((unsigned)d << 24);
}
__device__ __forceinline__ void cvi8_matrix(const float* W, int K, int N, int mode, unsigned char* WT, const gu32* amax, LAS unsigned char* T, int first, int stride, int lane) {
    const int nblk = N / 64, nitems = (K / 64) * nblk;
    if (first >= nitems) return;
    CvMat m; m.W = W; m.WT = nullptr; m.K = K; m.N = N; m.mode = mode;
    f32x4 v[16];
    cv_load(m, first, lane, v);
    for (int it = first; it < nitems; it += stride) {
        const int kb = it / nblk, nb = it % nblk, k0 = 64 * kb, n0 = 64 * nb;
        { const int kq = lane >> 4, nq = 4 * (lane & 15);
          const v4u am = *(const GAS v4u*)(amax + n0 + nq);
          f32x4 inv; inv.x = 127.0f / fmaxf(__uint_as_float(am.x), 1e-30f); inv.y = 127.0f / fmaxf(__uint_as_float(am.y), 1e-30f); inv.z = 127.0f / fmaxf(__uint_as_float(am.z), 1e-30f); inv.w = 127.0f / fmaxf(__uint_as_float(am.w), 1e-30f);
#pragma unroll
          for (int i = 0; i < 16; ++i) *(LAS unsigned*)(T + (4 * i + kq) * 68 + nq) = q8pack(v[i] * inv); }
        LDS_WAIT(); asm volatile("" ::: "memory");
        if (it + stride < nitems) cv_load(m, it + stride, lane, v);
        const int orow0 = mode == 0 ? n0 : (256 * (n0 >> 7) + (n0 & 127) + 128 * (mode - 1));
        const int c = lane & 3, nl = lane >> 2;
#pragma unroll
        for (int p = 0; p < 4; ++p) { const int n = 16 * p + nl; const LAS unsigned char* s = T + (16 * c) * 68 + n;
            v4u o;
            o.x = (unsigned)s[0 * 68] | ((unsigned)s[1 * 68] << 8) | ((unsigned)s[2 * 68] << 16) | ((unsigned)s[3 * 68] << 24);
            o.y = (unsigned)s[4 * 68] | ((unsigned)s[5 * 68] << 8) | ((unsigned)s[6 * 68] << 16) | ((unsigned)s[7 * 68] << 24);
            o.z = (unsigned)s[8 * 68] | ((unsigned)s[9 * 68] << 8) | ((unsigned)s[10 * 68] << 16) | ((unsigned)s[11 * 68] << 24);
            o.w = (unsigned)s[12 * 68] | ((unsigned)s[13 * 68] << 8) | ((unsigned)s[14 * 68] << 16) | ((unsigned)s[15 * 68] << 24);
            *(GAS v4u*)(WT + (size_t)(orow0 + n) * K + k0 + 16 * c) = o; }
        LDS_WAIT(); asm volatile("" ::: "memory");
    }
}
__device__ __forceinline__ void w13_convert8(const float* w1, const float* w3, unsigned char* WT, const gu32* amax1, const gu32* amax3, LAS unsigned char* lds, int gw, int NGW, int wave, int lane) {
    LAS unsigned char* T = lds + wave * CV_TILE_BYTES;
    constexpr int NIT = (DM / 64) * (DFF / 64);
    cvi8_matrix(w1, DM, DFF, 1, WT, amax1, T, gw, NGW, lane);
    int first = (gw - NIT) % NGW; if (first < 0) first += NGW;
    cvi8_matrix(w3, DM, DFF, 2, WT, amax3, T, first, NGW, lane);
}
__device__ __forceinline__ void strip_convert_i8(const float* W, int mode, unsigned char* WT, float* amaxOut, LAS float* red  , int strip, int wave, int lane) {
    const int n0 = strip * 32, c = lane & 31, kh = lane >> 5, n = n0 + c;
    const __amdgpu_buffer_rsrc_t rw = mkrsrc(W + (size_t)(wave * 512) * DFF, 512u * DFF * 4u);
    int voff = (kh * 256 * DFF + n) * 4; asm volatile("" : "+v"(voff));
    unsigned pk[128]; float mx = 0.f;
#pragma unroll
    for (int blk = 0; blk < 8; ++blk) {
        float t[32];
#pragma unroll
        for (int u = 0; u < 32; ++u) t[u] = __uint_as_float(__builtin_amdgcn_raw_buffer_load_b32(rw, voff + (32 * blk + u) * DFF * 4, 0, 2));
#pragma unroll
        for (int u = 0; u < 16; ++u) { mx = fmaxf(mx, fmaxf(fabsf(t[2 * u]), fabsf(t[2 * u + 1]))); pk[16 * blk + u] = pk2(t[2 * u], t[2 * u + 1]); }
        asm volatile("" : "+v"(pk[16 * blk]), "+v"(pk[16 * blk + 1]), "+v"(pk[16 * blk + 2]), "+v"(pk[16 * blk + 3]), "+v"(pk[16 * blk + 4]), "+v"(pk[16 * blk + 5]), "+v"(pk[16 * blk + 6]), "+v"(pk[16 * blk + 7]),
                         "+v"(pk[16 * blk + 8]), "+v"(pk[16 * blk + 9]), "+v"(pk[16 * blk + 10]), "+v"(pk[16 * blk + 11]), "+v"(pk[16 * blk + 12]), "+v"(pk[16 * blk + 13]), "+v"(pk[16 * blk + 14]), "+v"(pk[16 * blk + 15]) :: "memory");
    }
    mx = fmaxf(mx, __shfl_xor(mx, 32));
    if (kh == 0) red[wave * 32 + c] = mx;
    __syncthreads();
    float am = red[c];
#pragma unroll
    for (int w = 1; w < 8; ++w) am = fmaxf(am, red[w * 32 + c]);
    if (wave == 0 && kh == 0) amaxOut[n] = am;
    const float inv = 127.0f / fmaxf(am, 1e-30f);
    const int orow = mode == 0 ? n : (256 * (n >> 7) + (n & 127) + 128 * (mode - 1));
    const __amdgpu_buffer_rsrc_t ro = mkrsrc(WT, 0xffffffffu);
    const int vo = orow * DM + wave * 512 + kh * 256;
#pragma unroll
    for (int j = 0; j < 16; ++j) {
        v4u o;
#pragma unroll
        for (int q = 0; q < 4; ++q) { const unsigned p0 = pk[8 * j + 2 * q], p1 = pk[8 * j + 2 * q + 1];
            const f32x4 s = (f32x4){bf_lo(p0), bf_hi(p0), bf_lo(p1), bf_hi(p1)} * inv; o[q] = q8pack(s); }
        __builtin_amdgcn_raw_buffer_store_b128(o, ro, vo, 16 * j, 0); }
    __syncthreads();
}
__device__ __forceinline__ void w13_strips_i8(const float* w1, const float* w3, unsigned char* WT, float* amax1, float* amax3, LAS unsigned char* lds, int vcu, int G, int wave, int lane) {
    constexpr int NS = DFF / 32;
    for (int s = vcu; s < 2 * NS; s += G) {
        if (s < NS) strip_convert_i8(w1, 1, WT, amax1, (LAS float*)lds, s, wave, lane);
        else strip_convert_i8(w3, 2, WT, amax3, (LAS float*)lds, s - NS, wave, lane);
    }
}
struct WPtrs { const float *f1w1, *f1w3, *f1w2, *f2w1, *f2w3, *f2w2, *win, *wout, *wpool; bf16 *W13A, *W2A, *W13B, *W2B, *WIN, *WOUT, *WPT; };
__device__ __forceinline__ void p0_convert(const WPtrs& P, LAS unsigned char* lds, int gw, int NGW, int wave, int lane, int m_lo, int m_hi) {
    LAS unsigned short* T = (LAS unsigned short*)(lds + wave * CV_TILE_BYTES);
    int cum = 0;
#pragma unroll 1
    for (int mi = m_lo; mi < m_hi; ++mi) {
        CvMat m;
        if (mi == 0)      { m.W = P.f1w1; m.WT = P.W13A; m.K = DM; m.N = DFF; m.mode = 1; }
        else if (mi == 1) { m.W = P.f1w3; m.WT = P.W13A; m.K = DM; m.N = DFF; m.mode = 2; }
        else if (mi < 6)  { m.W = P.wpool + (size_t)(mi - 2) * 65536; m.WT = P.WPT + (size_t)(mi - 2) * 65536; m.K = 256; m.N = 256; m.mode = 0; }
        else if (mi == 6) { m.W = P.win;  m.WT = P.WIN;  m.K = DM; m.N = DIN; m.mode = 0; }
        else if (mi == 7) { m.W = P.wout; m.WT = P.WOUT; m.K = DM; m.N = DM;  m.mode = 0; }
        else if (mi == 8) { m.W = P.f2w1; m.WT = P.W13B; m.K = DM; m.N = DFF; m.mode = 1; }
        else              { m.W = P.f2w3; m.WT = P.W13B; m.K = DM; m.N = DFF; m.mode = 2; }
        const int nitems = (m.K / 64) * (m.N / 64);
        int first = (gw - cum) % NGW; if (first < 0) first += NGW;
        cv_matrix(m, T, first, NGW, lane);
        cum += nitems;
    }
}
constexpr int W2_ITEMS = (DFF / 64) * (DM / 64), W2_SPLIT = (W2_ITEMS * W2_IDLE_PCT) / 100;
__device__ __forceinline__ void w2_convert(const float* W, bf16* WT, LAS unsigned char* lds, int rank, int nconv, int wave, int lane, int it_lo, int it_hi) {
    LAS unsigned short* T = (LAS unsigned short*)(lds + wave * CV_TILE_BYTES);
    CvMat m; m.W = W; m.WT = WT; m.K = DFF; m.N = DM; m.mode = 0;
    cv_matrix(m, T, rank * NWAVES + wave, nconv * NWAVES, lane, it_lo, it_hi);
}

__device__ __forceinline__ void w2_convert8(const float* W, unsigned char* WT, float scale, LAS unsigned char* lds, int rank, int nconv, int wave, int lane) {
    cv8_matrix(W, DFF, DM, WT, scale, lds + wave * CV_TILE_BYTES, rank * NWAVES + wave, nconv * NWAVES, lane);
}

__device__ __forceinline__ float sumsq4(f32x4 v) { return (v.x * v.x + v.y * v.y) + (v.z * v.z + v.w * v.w); }
#define RP_LD4(rs, j) __builtin_bit_cast(f32x4, __builtin_amdgcn_raw_buffer_load_b128((rs), lo16, 1024 * (j), 0))
#define RP_LD4NT(rs, j) __builtin_bit_cast(f32x4, __builtin_amdgcn_raw_buffer_load_b128((rs), lo16, 1024 * (j), 2))
#define RP_ST4NT(rs, j, val) __builtin_amdgcn_raw_buffer_store_b128(__builtin_bit_cast(v4u, (val)), (rs), lo16, 1024 * (j), 2)
#define RP_ST4(rs, j, val) __builtin_amdgcn_raw_buffer_store_b128(__builtin_bit_cast(v4u, (val)), (rs), lo16, 1024 * (j), 0)
#define RP_ST8(rs, j, a, b) __builtin_amdgcn_raw_buffer_store_b64((v2u){(a), (b)}, (rs), lo8, 512 * (j), 0)
__device__ __forceinline__ f32x4 bf4_to_f32(v2u w) { return (f32x4){bf_lo(w.x), bf_hi(w.x), bf_lo(w.y), bf_hi(w.y)}; }
#define RP_LDB4(rs, j) bf4_to_f32(__builtin_amdgcn_raw_buffer_load_b64((rs), lo8, 512 * (j), 0))
#define RP_LDB4NT(rs, j) bf4_to_f32(__builtin_amdgcn_raw_buffer_load_b64((rs), lo8, 512 * (j), 2))
#define RP_ST4B(rs_, j, val) __builtin_amdgcn_raw_buffer_store_b32((val), (rs_), lo4, 256 * (j), 0)
__device__ __forceinline__ float amax4(f32x4 v) { return fmaxf(fmaxf(fabsf(v.x), fabsf(v.y)), fmaxf(fabsf(v.z), fabsf(v.w))); }
template <bool Q8>
__device__ __forceinline__ void rowpass_first(const float* x, const float* g, const float* mod_sub  , bf16* XN, float* rs, int gw, int NGW, int lane) {
    const int lo16 = lane * 16, lo8 = lane * 8, lo4 = lane * 4;
    const __amdgpu_buffer_rsrc_t rg = mkrsrc(g, DM * 4);
    for (int m = gw; m < M; m += NGW) {
        const int b = m / SEQ;
        const __amdgpu_buffer_rsrc_t rx = mkrsrc(x + (size_t)m * DM, DM * 4), rsh = mkrsrc(mod_sub + (size_t)b * NMOD, DM * 4), rsc = mkrsrc(mod_sub + (size_t)b * NMOD + DM, DM * 4);
        f32x4 v[16]; float ss = 0.f;
#pragma unroll
        for (int j = 0; j < 16; ++j) { v[j] = RP_LD4NT(rx, j); ss += sumsq4(v[j]); }
        const float rstd = 1.f / sqrtf(wave_sum(ss) * (1.f / DM) + EPS);
        if constexpr (Q8) {
            const __amdgpu_buffer_rsrc_t ro = mkrsrc((unsigned char*)XN + (size_t)m * DM, DM);
            float mx = 0.f;
#pragma unroll
            for (int j = 0; j < 16; ++j) { const f32x4 gg = RP_LD4(rg, j), sh = RP_LD4(rsh, j), sc = RP_LD4(rsc, j); v[j] = (v[j] * rstd * gg) * (sc + 1.0f) + sh; mx = fmaxf(mx, amax4(v[j])); }
            const float am = fmaxf(wave_max(mx), 1e-20f), inv = 127.0f / am;
#pragma unroll
            for (int j = 0; j < 16; ++j) RP_ST4B(ro, j, q8pack(v[j] * inv));
            if (lane == 0) rs[m] = am * (1.0f / 127.0f);
        } else {
            const __amdgpu_buffer_rsrc_t ro = mkrsrc(XN + (size_t)m * DM, DM * 2);
#pragma unroll
            for (int j = 0; j < 16; ++j) { const f32x4 gg = RP_LD4(rg, j), sh = RP_LD4(rsh, j), sc = RP_LD4(rsc, j);
                const f32x4 h = (v[j] * rstd * gg) * (sc + 1.0f) + sh;
                RP_ST8(ro, j, pk2(h.x, h.y), pk2(h.z, h.w)); }
        }
    }
}
template <bool Q8, bool XIB, bool XOB>
__device__ __forceinline__ void rowpass_mid(const bf16* F, const void* xi, void* xo, bf16* XN, float* rs, const float* gpost, const float* gpre, const float* mod_cur  ,
                                            const float* mod_nxt  , float gmul, int gw, int NGW, int lane) {
    const int lo16 = lane * 16, lo8 = lane * 8, lo4 = lane * 4;
    const __amdgpu_buffer_rsrc_t rgpo = mkrsrc(gpost, DM * 4), rgpr = mkrsrc(gpre, DM * 4);
    for (int m = gw; m < M; m += NGW) {
        const int b = m / SEQ;
        const __amdgpu_buffer_rsrc_t rf_ = mkrsrc(F + (size_t)m * DM, DM * 2), rx = mkrsrc((const char*)xi + (size_t)m * DM * (XIB ? 2 : 4), DM * (XIB ? 2 : 4)), rw = mkrsrc((char*)xo + (size_t)m * DM * (XOB ? 2 : 4), DM * (XOB ? 2 : 4));
        const __amdgpu_buffer_rsrc_t rga = mkrsrc(mod_cur + (size_t)b * NMOD + 2 * DM, DM * 4), rsh = mkrsrc(mod_nxt + (size_t)b * NMOD, DM * 4), rsc = mkrsrc(mod_nxt + (size_t)b * NMOD + DM, DM * 4);
        f32x4 f[16], v[16]; float ss = 0.f;
#pragma unroll
        for (int j = 0; j < 16; ++j) { f[j] = RP_LDB4NT(rf_, j); ss += sumsq4(f[j]); }
#pragma unroll
        for (int j = 0; j < 16; ++j) { if constexpr (XIB) v[j] = RP_LDB4NT(rx, j); else v[j] = RP_LD4NT(rx, j); }
        const float rf = gmul / sqrtf(wave_sum(ss) * (1.f / DM) + EPS);
        float s2 = 0.f;
#pragma unroll
        for (int j = 0; j < 16; ++j) { const f32x4 gg = RP_LD4(rgpo, j), ga = RP_LD4(rga, j); v[j] = v[j] + ga * (f[j] * rf * gg);
            if constexpr (XOB) __builtin_amdgcn_raw_buffer_store_b64((v2u){pk2(v[j].x, v[j].y), pk2(v[j].z, v[j].w)}, rw, lo8, 512 * j, 2); else RP_ST4(rw, j, v[j]);
            s2 += sumsq4(v[j]); }
        const float rstd = 1.f / sqrtf(wave_sum(s2) * (1.f / DM) + EPS);
        if constexpr (Q8) {
            const __amdgpu_buffer_rsrc_t ro = mkrsrc((unsigned char*)XN + (size_t)m * DM, DM);
            float mx = 0.f;
#pragma unroll
            for (int j = 0; j < 16; ++j) { const f32x4 gg = RP_LD4(rgpr, j), sh = RP_LD4(rsh, j), sc = RP_LD4(rsc, j); v[j] = (v[j] * rstd * gg) * (sc + 1.0f) + sh; mx = fmaxf(mx, amax4(v[j])); }
            const float am = fmaxf(wave_max(mx), 1e-20f), inv = 127.0f / am;
#pragma unroll
            for (int j = 0; j < 16; ++j) RP_ST4B(ro, j, q8pack(v[j] * inv));
            if (lane == 0) rs[m] = am * (1.0f / 127.0f);
        } else {
            const __amdgpu_buffer_rsrc_t ro = mkrsrc(XN + (size_t)m * DM, DM * 2);
#pragma unroll
            for (int j = 0; j < 16; ++j) { const f32x4 gg = RP_LD4(rgpr, j), sh = RP_LD4(rsh, j), sc = RP_LD4(rsc, j);
                const f32x4 h = (v[j] * rstd * gg) * (sc + 1.0f) + sh;
                RP_ST8(ro, j, pk2(h.x, h.y), pk2(h.z, h.w)); }
        }
    }
}
template <bool XIB>
__device__ __forceinline__ void rowpass_last(const bf16* F, const void* xi, float* xo, const float* gpost, const float* mod_cur, float gmul, int gw, int NGW, int lane) {
    const int lo16 = lane * 16, lo8 = lane * 8;
    const __amdgpu_buffer_rsrc_t rgpo = mkrsrc(gpost, DM * 4);
    for (int m = gw; m < M; m += NGW) {
        const int b = m / SEQ;
        const __amdgpu_buffer_rsrc_t rf_ = mkrsrc(F + (size_t)m * DM, DM * 2), rx = mkrsrc((const char*)xi + (size_t)m * DM * (XIB ? 2 : 4), DM * (XIB ? 2 : 4)), rw = mkrsrc(xo + (size_t)m * DM, DM * 4);
        const __amdgpu_buffer_rsrc_t rga = mkrsrc(mod_cur + (size_t)b * NMOD + 2 * DM, DM * 4);
        f32x4 f[16], v[16]; float ss = 0.f;
#pragma unroll
        for (int j = 0; j < 16; ++j) { f[j] = RP_LDB4NT(rf_, j); ss += sumsq4(f[j]); }
#pragma unroll
        for (int j = 0; j < 16; ++j) { if constexpr (XIB) v[j] = RP_LDB4NT(rx, j); else v[j] = RP_LD4NT(rx, j); }
        const float rf = gmul / sqrtf(wave_sum(ss) * (1.f / DM) + EPS);
#pragma unroll
        for (int j = 0; j < 16; ++j) { const f32x4 gg = RP_LD4(rgpo, j), ga = RP_LD4(rga, j); RP_ST4NT(rw, j, v[j] + ga * (f[j] * rf * gg)); }
    }
}

__device__ __forceinline__ void pool_task(const bf16* U, const bf16* WPT, const float* pool_scale, bf16* MIX, int task, int lane) {
    const int g = task & 3, rb = task >> 2, w = 2 << g, fr = lane & 15, fq = lane >> 4, t = rb * 16 + fr, ts = t & (SEQ - 1);
    const int cnt = (ts + 1) < w ? (ts + 1) : w; const float inv = 1.f / (float)cnt;
    f32x4 acc[16];
#pragma unroll
    for (int n = 0; n < 16; ++n) acc[n] = (f32x4){0.f, 0.f, 0.f, 0.f};
    const bf16* up = U + (size_t)t * DPOOL + g * 256 + 8 * fq;
    const bf16* wp = WPT + (size_t)g * 65536 + (size_t)fr * 256 + 8 * fq;
    for (int ks = 0; ks < 8; ++ks) {
        float s[8];
#pragma unroll
        for (int i = 0; i < 8; ++i) s[i] = 0.f;
        for (int j = 0; j < w; ++j) {
            if (j < cnt) { const v4u r = *(const GAS v4u*)(up + ks * 32 - (size_t)j * DPOOL);
                s[0] += bf_lo(r.x); s[1] += bf_hi(r.x); s[2] += bf_lo(r.y); s[3] += bf_hi(r.y); s[4] += bf_lo(r.z); s[5] += bf_hi(r.z); s[6] += bf_lo(r.w); s[7] += bf_hi(r.w); }
        }
        const v4u own = *(const GAS v4u*)(up + ks * 32);
        v4u aw;
        aw.x = pk2(s[0] * inv - bf_lo(own.x), s[1] * inv - bf_hi(own.x)); aw.y = pk2(s[2] * inv - bf_lo(own.y), s[3] * inv - bf_hi(own.y));
        aw.z = pk2(s[4] * inv - bf_lo(own.z), s[5] * inv - bf_hi(own.z)); aw.w = pk2(s[6] * inv - bf_lo(own.w), s[7] * inv - bf_hi(own.w));
        const bf16x8 af = __builtin_bit_cast(bf16x8, aw);
#pragma unroll
        for (int n = 0; n < 16; ++n) { const bf16x8 bfr = *(const GAS bf16x8*)(wp + (size_t)n * 16 * 256 + ks * 32);
            acc[n] = __builtin_amdgcn_mfma_f32_16x16x32_bf16(bfr, af, acc[n], 0, 0, 0); }
    }
    bf16* op = MIX + (size_t)t * DM + g * 256 + 4 * fq; const float* psp = pool_scale + g * 256 + 4 * fq;
#pragma unroll
    for (int n = 0; n < 16; ++n) { const f32x4 ps = *(const GAS f32x4*)(psp + n * 16); const f32x4 o = acc[n] * ps;
        *(GAS unsigned long long*)(op + n * 16) = (unsigned long long)pk2(o.x, o.y) | ((unsigned long long)pk2(o.z, o.w) << 32); }
}

__device__ __forceinline__ void combine_phase(const bf16* O4, const float* subln_g, const float* lq1, const float* lk1, const float* lq2, const float* lk2, bf16* MIX, int gw, int NGW, int lane) {
    const float s1 = wave_sum(lq1[lane] * lk1[lane] + lq1[lane + 64] * lk1[lane + 64]), s2 = wave_sum(lq2[lane] * lk2[lane] + lq2[lane + 64] * lk2[lane + 64]);
    const float lam = __expf(s1) - __expf(s2) + LAMBDA_INIT;
    const int l16 = lane & 15, hq = lane >> 4, half = l16 >> 3, e0 = (l16 & 7) * 16;
    f32x4 gsub[4];
#pragma unroll
    for (int i = 0; i < 4; ++i) gsub[i] = *(const GAS f32x4*)(subln_g + half * 128 + e0 + 4 * i) * ONE_MINUS_LAMBDA_INIT;
    for (int task = gw; task < M * 3; task += NGW) {
        const int t = task / 3, h = (task % 3) * 4 + hq, b = t / SEQ, s = t % SEQ;
#if ATTN_V2
        const bf16* p1 = O4 + (((size_t)(b * NH + h) * 2 + 0) * SEQ + s) * 256 + half * 128 + e0;
        const bf16* p2 = p1 + (size_t)SEQ * 256;
#else
        const bf16* p1 = O4 + ((((size_t)(b * NH + h) * 2 + 0) * 2 + half) * SEQ + s) * 128 + e0;
        const bf16* p2 = p1 + (size_t)2 * SEQ * 128;
#endif
        const v4u a0 = __builtin_nontemporal_load((const GAS v4u*)p1), a1 = __builtin_nontemporal_load((const GAS v4u*)(p1 + 8)), c0 = __builtin_nontemporal_load((const GAS v4u*)p2), c1 = __builtin_nontemporal_load((const GAS v4u*)(p2 + 8));
        float o[16];
        o[0] = bf_lo(a0.x) - lam * bf_lo(c0.x); o[1] = bf_hi(a0.x) - lam * bf_hi(c0.x); o[2] = bf_lo(a0.y) - lam * bf_lo(c0.y); o[3] = bf_hi(a0.y) - lam * bf_hi(c0.y);
        o[4] = bf_lo(a0.z) - lam * bf_lo(c0.z); o[5] = bf_hi(a0.z) - lam * bf_hi(c0.z); o[6] = bf_lo(a0.w) - lam * bf_lo(c0.w); o[7] = bf_hi(a0.w) - lam * bf_hi(c0.w);
        o[8] = bf_lo(a1.x) - lam * bf_lo(c1.x); o[9] = bf_hi(a1.x) - lam * bf_hi(c1.x); o[10] = bf_lo(a1.y) - lam * bf_lo(c1.y); o[11] = bf_hi(a1.y) - lam * bf_hi(c1.y);
        o[12] = bf_lo(a1.z) - lam * bf_lo(c1.z); o[13] = bf_hi(a1.z) - lam * bf_hi(c1.z); o[14] = bf_lo(a1.w) - lam * bf_lo(c1.w); o[15] = bf_hi(a1.w) - lam * bf_hi(c1.w);
        float ss = 0.f;
#pragma unroll
        for (int i = 0; i < 16; ++i) ss += o[i] * o[i];
        ss += __shfl_xor(ss, 1); ss += __shfl_xor(ss, 2); ss += __shfl_xor(ss, 4); ss += __shfl_xor(ss, 8);
        const float rstd = 1.f / sqrtf(ss * (1.f / 256.f) + EPS);
        v4u w0, w1;
        w0.x = pk2(o[0] * rstd * gsub[0].x, o[1] * rstd * gsub[0].y); w0.y = pk2(o[2] * rstd * gsub[0].z, o[3] * rstd * gsub[0].w);
        w0.z = pk2(o[4] * rstd * gsub[1].x, o[5] * rstd * gsub[1].y); w0.w = pk2(o[6] * rstd * gsub[1].z, o[7] * rstd * gsub[1].w);
        w1.x = pk2(o[8] * rstd * gsub[2].x, o[9] * rstd * gsub[2].y); w1.y = pk2(o[10] * rstd * gsub[2].z, o[11] * rstd * gsub[2].w);
        w1.z = pk2(o[12] * rstd * gsub[3].x, o[13] * rstd * gsub[3].y); w1.w = pk2(o[14] * rstd * gsub[3].z, o[15] * rstd * gsub[3].w);
        bf16* op = MIX + (size_t)t * DM + DPOOL + h * 256 + half * 128 + e0;
        *(GAS v4u*)op = w0; *(GAS v4u*)(op + 8) = w1;
    }
}

__device__ __forceinline__ attn::BlockRef<attn::bf16, attn::bf16> attn_ref(const bf16* QKV, bf16* O4, int L, int pass) {
    const int x = L & 3, vh = L >> 2, half = vh & 1, map = (vh >> 1) & 1, bh = vh >> 2, b = bh / NH, h = bh % NH, qb = pass ? 7 - x : x;
    constexpr size_t SL = (size_t)SEQ * 128;
    attn::BlockRef<attn::bf16, attn::bf16> r;
    r.Q = (const attn::bf16*)QKV + ((size_t)((0 * 4 + b) * 24 + h * 2 + map)) * SL + (size_t)qb * 256 * 128;
    r.K = (const attn::bf16*)QKV + ((size_t)((1 * 4 + b) * 24 + h * 2 + map)) * SL;
    r.V = (const attn::bf16*)QKV + ((size_t)((2 * 4 + b) * 24 + h * 2 + half)) * SL;
    r.O = (attn::bf16*)O4 + ((size_t)(((b * NH + h) * 2 + map) * 2 + half)) * SL + (size_t)qb * 256 * 128;
    r.P0 = qb * 256;
    return r;
}
__device__ __forceinline__ void attn_phase(const bf16* QKV, bf16* O4, char* lds, int vcu, int G, const int tid) {
    constexpr int NITEMS = NB * NH * 2 * 2 * 4;
    const int per = (NITEMS + G - 1) / G, L0 = vcu * per, L1 = (L0 + per) < NITEMS ? (L0 + per) : NITEMS;
    if (L0 >= L1) return;
    int L = L0, pass = 0;
    attn::BlockRef<attn::bf16, attn::bf16> cur = attn_ref(QKV, O4, L, 0);
    attn::Seam<attn::bf16> S;
    attn::causal_swa_prime<attn::bf16, attn::bf16>(cur, SEQ, lds, S, tid);
    for (;;) {
        const bool more_pass = pass == 0, more_item = L + 1 < L1, last = !more_pass && !more_item;
        int passn = pass + 1, Ln = L;
        if (!more_pass) { passn = 0; Ln = more_item ? L + 1 : L; }
        const attn::BlockRef<attn::bf16, attn::bf16> nxt = last ? cur : attn_ref(QKV, O4, Ln, passn);
        attn::causal_swa_block<attn::bf16, attn::bf16>(cur, nxt, SEQ, SEQ, lds, S, tid);
        if (last) break;
        cur = nxt; pass = passn; L = Ln;
    }
}

__device__ __forceinline__ void attn_phase_v2(const bf16* QKV, bf16* O, LAS unsigned char* lds, int vcu, int G, int wave, int lane) {
    constexpr size_t SL = (size_t)SEQ * 128;
    for (int u = vcu; u < 256; u += G) {
        const int gi = u >> 3, j = u & 7;
#pragma unroll 1
        for (int k = 0; k < 3; ++k) {
            const unsigned tab = k == 0 ? 0x76543210u : (k == 1 ? 0x10576243u : 0x34102657u);
            const int qb = (int)((tab >> (4 * j)) & 15u), hh = 3 * gi + k, map = hh & 1, bh = hh >> 1, b = bh / NH, h = bh % NH;
            attx::Block B;
            B.Q = QKV + ((size_t)((0 * 4 + b) * 24 + h * 2 + map)) * SL;
            B.K = QKV + ((size_t)((1 * 4 + b) * 24 + h * 2 + map)) * SL;
            B.V0 = QKV + ((size_t)((2 * 4 + b) * 24 + h * 2 + 0)) * SL;
            B.V1 = QKV + ((size_t)((2 * 4 + b) * 24 + h * 2 + 1)) * SL;
            B.O = O + ((size_t)((b * NH + h) * 2 + map)) * SEQ * 256;
            B.qb = qb;
            int lane_ = lane; asm volatile("" : "+v"(lane_));
            attx::attn_block(B, lds, wave, lane_);
        }
    }
    asm volatile("s_waitcnt vmcnt(0)" ::: "memory"); __builtin_amdgcn_s_barrier();
}

struct Args { const float* in[21]; float* out; unsigned char* ws; int ph_lo, ph_hi; };
static_assert(sizeof(Args) == 24 * 8, "Args has no holes");
__global__ void __launch_bounds__(NWAVES * 64, 2) mk_fwd(Args args) {
    extern __shared__ __attribute__((aligned(16))) unsigned char lds[];
    LAS unsigned char* ldsl = (LAS unsigned char*)lds;
    volatile LAS unsigned* MISC = (volatile LAS unsigned*)(ldsl + MISC_OFF);
    const int wave = __builtin_amdgcn_readfirstlane(threadIdx.x >> 6);
#define MK_LANE() ({ int l_; asm volatile("v_mbcnt_lo_u32_b32 %0, -1, 0\n\tv_mbcnt_hi_u32_b32 %0, -1, %0" : "=v"(l_)); l_; })
    const int G = gridDim.x, bx = blockIdx.x, vcu = (G % 8 == 0) ? (bx % 8) * (G / 8) + bx / 8 : bx;
    const int gw = vcu * NWAVES + wave, NGW = G * NWAVES;
    unsigned char* ws = args.ws;
    gu32* ctl = (gu32*)(ws + WS_CTL);
    const float *x = args.in[0], *c = args.in[1], *w_ada = args.in[2], *b_ada = args.in[3], *pre_g = args.in[4], *post_g = args.in[5];
    const float *pool_scale = args.in[11], *lq1 = args.in[12], *lk1 = args.in[13], *lq2 = args.in[14], *lk2 = args.in[15], *subln_g = args.in[16];
    float* out = args.out;
    float* mod = (float*)(ws + WS_MOD);
    bf16 *WPT = (bf16*)(ws + WS_WPT), *W13A = (bf16*)(ws + WS_W13A), *W2A = (bf16*)(ws + WS_W2A), *W13B = (bf16*)(ws + WS_W13B), *W2B = (bf16*)(ws + WS_W2B), *WIN = (bf16*)(ws + WS_WIN), *WOUT = (bf16*)(ws + WS_WOUT);
    bf16 *XN = (bf16*)(ws + WS_XN), *ACT = (bf16*)(ws + WS_ACT), *U = (bf16*)(ws + WS_U), *QKV = (bf16*)(ws + WS_QKV), *O4 = (bf16*)(ws + WS_O4), *MIX = (bf16*)(ws + WS_MIX);
    bf16* F = (bf16*)(ws + WS_F);
    bf16* XR = (bf16*)(ws + WS_XR);

    { const int tid0 = wave * 64 + MK_LANE();
      for (int u = tid0; u < (LDS_BYTES - LDSCTL_OFF) / 4; u += NWAVES * 64) ((LAS unsigned*)(ldsl + LDSCTL_OFF))[u] = 0u; }
    __syncthreads();
    XcdBarrier bar; bar.bar = (unsigned*)(ctl + CW_BAR); bar.x = 0; bar.st = nullptr;
    if (N_LAUNCHES == 1) bar = xcd_barrier_post((unsigned*)(ctl + CW_BAR), MISC + 8);
#define GRID_BAR() do { if (N_LAUNCHES == 1) xcd_barrier(bar, wave * 64 + MK_LANE()); } while (0)
    const int lo = args.ph_lo, hi = args.ph_hi;
#define IN(k) (lo <= (k) && (k) < hi)
#ifndef PROBE_DUP
#define PROBE_DUP -1
#endif
#define REP(k) for (int rep_ = 0; rep_ < ((PROBE_DUP == (k)) ? 2 : 1); ++rep_)
#define BOTH(k) (IN(k) && IN((k) + 1))

    gu32* AM = ctl + CW_AMAX;
    float* RS = (float*)(ws + WS_RS);
    if (IN(0)) REP(0) {
        const int lane = MK_LANE(), tid = wave * 64 + lane;
        p0_adaln(c, w_ada, b_ada, mod, ldsl, vcu, G, tid);
        WPtrs P{args.in[6], args.in[7], args.in[8], args.in[18], args.in[19], args.in[20], args.in[9], args.in[17], args.in[10], W13A, W2A, W13B, W2B, WIN, WOUT, WPT};
#if FFN_UP_INT8
        p0_convert(P, ldsl, gw, NGW, wave, lane, 2, 6);
#else
        p0_convert(P, ldsl, gw, NGW, wave, lane, 0, CV_SPLIT ? 6 : 10);
#endif
        if (BOTH(0)) GRID_BAR();
    }
    if (IN(1)) REP(1) {
#if FFN_UP_INT8
        rowpass_first<true>(x, pre_g, mod, XN, RS, gw, NGW, MK_LANE());
        w13_strips_i8(args.in[6], args.in[7], (unsigned char*)W13A, (float*)(unsigned*)AM, (float*)(unsigned*)(AM + DFF), ldsl, vcu, G, wave, MK_LANE());
        w2_convert(args.in[8], W2A, ldsl, vcu, G, wave, MK_LANE(), W2_SPLIT, W2_ITEMS);
#else
        rowpass_first<false>(x, pre_g, mod, XN, RS, gw, NGW, MK_LANE());
#endif
        if (BOTH(1)) GRID_BAR(); }
    if (IN(2)) REP(2) {
        pg8::Gemm g{XN, W13A, M, 2 * DFF, DM}; pg8::StaticOrder S; S.init(M, 2 * DFF, G, bx, UP_WGM);
#if FFN_UP_INT8
        pg8::EpiSwiGLUi8 E{ACT, DFF, RS, (const float*)(unsigned*)AM, (const float*)(unsigned*)(AM + DFF)};
        pg8::gemm_phase<pg8::EpiSwiGLUi8, pg8::StaticOrder, true, true, 2>(ldsl + RING_OFF, g, S, E, wave * 64 + MK_LANE());
#else
        pg8::EpiSwiGLU E{ACT, DFF};
        pg8::gemm_phase<pg8::EpiSwiGLU, pg8::StaticOrder, true, true>(ldsl + RING_OFF, g, S, E, wave * 64 + MK_LANE());
#endif
        { const int rem = S.nwg % G, nconv = rem ? G - rem : G, rank = rem ? bx - rem : bx;
          if (rank >= 0) w2_convert(args.in[8], W2A, ldsl, rank, nconv, wave, MK_LANE(), 0, W2_SPLIT); }
        if (BOTH(2)) GRID_BAR();
    }
#ifdef PROBE_IDLE_US
    if (IN(3)) { const unsigned long long t0_ = __builtin_amdgcn_s_memrealtime(); while (__builtin_amdgcn_s_memrealtime() - t0_ < (unsigned long long)PROBE_IDLE_US * 100ull) __builtin_amdgcn_s_sleep(32); }
#endif
    if (IN(3)) REP(3) {
        pg8::Gemm g{ACT, W2A, M, DM, DFF}; pg8::StaticOrder S; S.init(M, DM, G, bx);
        pg8::EpiBf16P E{F, DM};
        pg8::gemm_phase<pg8::EpiBf16P, pg8::StaticOrder, true, true, 0, DOWN_AUXA, DOWN_AUXB>(ldsl + RING_OFF, g, S, E, wave * 64 + MK_LANE());
        if (BOTH(3)) GRID_BAR();
    }
    if (IN(4)) REP(4) { rowpass_mid<false, false, true>(F, x, XR, XN, RS, post_g, pre_g + DM, mod, mod + 3 * DM, 0.5f, gw, NGW, MK_LANE());
        if (CV_SPLIT) { WPtrs P{args.in[6], args.in[7], args.in[8], args.in[18], args.in[19], args.in[20], args.in[9], args.in[17], args.in[10], W13A, W2A, W13B, W2B, WIN, WOUT, WPT};
            p0_convert(P, ldsl, gw, NGW, wave, MK_LANE(), 6, 8); }
        if (BOTH(4)) GRID_BAR(); }
    if (IN(5)) REP(5) {
        pg8::Gemm g{XN, WIN, M, DIN, DM}; pg8::StaticOrder S; S.init(M, DIN, G, bx);
        pg8::EpiProj E{U, QKV};
        pg8::gemm_phase<pg8::EpiProj, pg8::StaticOrder, true, true>(ldsl + RING_OFF, g, S, E, wave * 64 + MK_LANE());
        if (BOTH(5)) GRID_BAR();
    }
    if (IN(6)) REP(6) {
        { const int lane = MK_LANE(); for (int task = gw; task < (M / 16) * 4; task += NGW) pool_task(U, WPT, pool_scale, MIX, task, lane); }
#if ATTN_V2
        attn_phase_v2(QKV, O4, ldsl + RING_OFF, vcu, G, wave, MK_LANE());
#else
        attn_phase(QKV, O4, (char*)lds + RING_OFF, vcu, G, wave * 64 + MK_LANE());
#endif
        if (BOTH(6)) GRID_BAR();
    }
    if (IN(7)) REP(7) { combine_phase(O4, subln_g, lq1, lk1, lq2, lk2, MIX, gw, NGW, MK_LANE()); if (BOTH(7)) GRID_BAR(); }
    if (IN(8)) REP(8) {
        pg8::Gemm g{MIX, WOUT, M, DM, DM}; pg8::StaticOrder S; S.init(M, DM, G, bx);
        pg8::EpiBf16P E{F, DM};
        pg8::gemm_phase<pg8::EpiBf16P, pg8::StaticOrder, true, true>(ldsl + RING_OFF, g, S, E, wave * 64 + MK_LANE());
        if (BOTH(8)) GRID_BAR();
    }
    if (IN(9)) REP(9) {
#if FFN_UP_INT8
        rowpass_mid<true, true, true>(F, XR, XR, XN, RS, post_g + DM, pre_g + 2 * DM, mod + 3 * DM, mod + 6 * DM, 1.0f, gw, NGW, MK_LANE());
        w13_strips_i8(args.in[18], args.in[19], (unsigned char*)W13B, (float*)(unsigned*)(AM + 2 * DFF), (float*)(unsigned*)(AM + 3 * DFF), ldsl, vcu, G, wave, MK_LANE());
        w2_convert(args.in[20], W2B, ldsl, vcu, G, wave, MK_LANE(), W2_SPLIT, W2_ITEMS);
#else
        rowpass_mid<false, true, true>(F, XR, XR, XN, RS, post_g + DM, pre_g + 2 * DM, mod + 3 * DM, mod + 6 * DM, 1.0f, gw, NGW, MK_LANE());
        if (CV_SPLIT) { WPtrs P{args.in[6], args.in[7], args.in[8], args.in[18], args.in[19], args.in[20], args.in[9], args.in[17], args.in[10], W13A, W2A, W13B, W2B, WIN, WOUT, WPT};
            p0_convert(P, ldsl, gw, NGW, wave, MK_LANE(), 8, 10); }
#endif
        if (BOTH(9)) GRID_BAR(); }
    if (IN(10)) REP(10) {
        pg8::Gemm g{XN, W13B, M, 2 * DFF, DM}; pg8::StaticOrder S; S.init(M, 2 * DFF, G, bx, UP_WGM);
#if FFN_UP_INT8
        pg8::EpiSwiGLUi8 E{ACT, DFF, RS, (const float*)(unsigned*)(AM + 2 * DFF), (const float*)(unsigned*)(AM + 3 * DFF)};
        pg8::gemm_phase<pg8::EpiSwiGLUi8, pg8::StaticOrder, true, true, 2>(ldsl + RING_OFF, g, S, E, wave * 64 + MK_LANE());
#elif FFN2_DOWN_FP8
        pg8::EpiSwiGLU8 E{(unsigned char*)ACT, DFF, F8_SA};
        pg8::gemm_phase<pg8::EpiSwiGLU8, pg8::StaticOrder, true, true>(ldsl + RING_OFF, g, S, E, wave * 64 + MK_LANE());
#else
        pg8::EpiSwiGLU E{ACT, DFF};
        pg8::gemm_phase<pg8::EpiSwiGLU, pg8::StaticOrder, true, true>(ldsl + RING_OFF, g, S, E, wave * 64 + MK_LANE());
#endif
        { const int rem = S.nwg % G, nconv = rem ? G - rem : G, rank = rem ? bx - rem : bx;
#if FFN2_DOWN_FP8
          if (rank >= 0) w2_convert8(args.in[20], (unsigned char*)W2B, F8_SW, ldsl, rank, nconv, wave, MK_LANE()); }
#else
          if (rank >= 0) w2_convert(args.in[20], W2B, ldsl, rank, nconv, wave, MK_LANE(), 0, W2_SPLIT); }
#endif
        if (BOTH(10)) GRID_BAR();
    }
    if (IN(11)) REP(11) {
#if FFN2_DOWN_FP8
        pg8::Gemm g{ACT, W2B, M, DM, DFF}; pg8::StaticOrder S; S.init(M, DM, G, bx);
        pg8::EpiBf16S E{F, DM, 1.0f / (F8_SA * F8_SW)};
        pg8::gemm_phase<pg8::EpiBf16S, pg8::StaticOrder, true, true, 1>(ldsl + RING_OFF, g, S, E, wave * 64 + MK_LANE());
#else
        pg8::Gemm g{ACT, W2B, M, DM, DFF}; pg8::StaticOrder S; S.init(M, DM, G, bx);
        pg8::EpiBf16P E{F, DM};
        pg8::gemm_phase<pg8::EpiBf16P, pg8::StaticOrder, true, true, 0, DOWN_AUXA, DOWN_AUXB>(ldsl + RING_OFF, g, S, E, wave * 64 + MK_LANE());
#endif
        if (BOTH(11)) GRID_BAR();
    }
    if (IN(12)) REP(12) { rowpass_last<true>(F, XR, out, post_g + 2 * DM, mod + 6 * DM, 0.5f, gw, NGW, MK_LANE()); }
#undef IN
#undef BOTH
#undef GRID_BAR
}

extern "C" void kernel_launch(void* const* d_in, const int* in_sizes, int n_in, void* d_out, int out_size, void* d_ws, size_t ws_size, hipStream_t stream) {
    static int grid = 0;
    if (grid == 0) {
        if (n_in != 21 || in_sizes[0] != M * DM || out_size != M * DM || ws_size < WS_END) { fprintf(stderr, "kernel_launch: unexpected shapes (n_in %d, in0 %d, out %d, ws %zu); nothing launched\n", n_in, n_in > 0 ? in_sizes[0] : -1, out_size, ws_size); grid = -1; return; }
        int dev = 0, cus = 0, per_cu = 0;
        if (hipGetDevice(&dev) != hipSuccess || hipDeviceGetAttribute(&cus, hipDeviceAttributeMultiprocessorCount, dev) != hipSuccess) { fprintf(stderr, "kernel_launch: device query failed\n"); grid = -1; return; }
        if (hipFuncSetAttribute((const void*)mk_fwd, hipFuncAttributeMaxDynamicSharedMemorySize, LDS_BYTES) != hipSuccess) { fprintf(stderr, "kernel_launch: hipFuncSetAttribute failed\n"); grid = -1; return; }
        if (hipOccupancyMaxActiveBlocksPerMultiprocessor(&per_cu, (const void*)mk_fwd, NWAVES * 64, LDS_BYTES) != hipSuccess || per_cu < 1) fprintf(stderr, "kernel_launch: note: occupancy query reports %d workgroups per CU\n", per_cu);
        (void)hipGetLastError();
        grid = cus;
    }
    if (grid < 0) return;
    if (hipMemsetAsync((char*)d_ws + WS_CTL, 0, CTL_ZERO_BYTES, stream) != hipSuccess) { fprintf(stderr, "kernel_launch: hipMemsetAsync failed\n"); return; }
    Args a{};
    for (int i = 0; i < 21; ++i) a.in[i] = (const float*)d_in[i];
    a.out = (float*)d_out; a.ws = (unsigned char*)d_ws;
    for (int li = 0; li < N_LAUNCHES; ++li) {
        a.ph_lo = (N_LAUNCHES == 1) ? 0 : li; a.ph_hi = (N_LAUNCHES == 1) ? N_PHASES : li + 1;
        hipLaunchKernelGGL(mk_fwd, dim3(grid), dim3(NWAVES * 64), LDS_BYTES, stream, a);
        const hipError_t le = hipPeekAtLastError();
        if (le != hipSuccess) { fprintf(stderr, "kernel_launch: launch %d failed: %s\n", li, hipGetErrorName(le)); break; }
    }
}
```

```cpp
#include <hip/hip_runtime.h>
#include <hip/hip_bf16.h>
#include <cstdio>
#include <cstdint>
#include <cmath>
namespace pg8 {
#define PG8_LAS __attribute__((address_space(3)))
typedef unsigned short bf16_t;
typedef short bf16x8 __attribute__((ext_vector_type(8)));
typedef float f32x4 __attribute__((ext_vector_type(4)));
typedef unsigned u32x4 __attribute__((ext_vector_type(4)));
constexpr int BM = 256, BK = 64, HALF = 128, HTB = HALF * BK * 2  , STAGE_BYTES = 8 * HTB, NXCD = 8, WGM = 8;

__host__ __device__ __forceinline__ int lds_byte(int r, int c) { const int st = (r >> 4) * 2 + (c >> 5), rr = r & 15, cc = c & 31, ob = rr * 64 + cc * 2; return st * 1024 + (ob ^ (((ob >> 9) & 1) << 5)); }
__host__ __device__ __forceinline__ void stage_rc(int b, int& R, int& C) { const int st = b / 1024, sb = b % 1024, swz = sb ^ (((sb >> 9) & 1) << 5); R = (st >> 1) * 16 + swz / 64; C = (st & 1) * 32 + (swz % 64) / 2; }
__host__ __device__ __forceinline__ int perm32(int rho) { const int n = rho >> 4, i = rho & 15; return 8 * (i >> 2) + 4 * n + (i & 3); }

struct Unit { int pm, pn; };
struct Gemm { const bf16_t* A; const bf16_t* Bt; int M, N, K; };

struct StaticOrder {
    int nM, nN, nwg, G, c;
    __host__ __device__ void init(int M, int N, int G_, int c_) { nM = M / BM; nN = N / BM; nwg = nM * nN; G = G_; c = c_; }
    __host__ __device__ bool next(int i, Unit& u) const {
        const long L = (long)i * G + c; if (L >= nwg) return false;
        int wgid = (int)L; { const int q = nwg / NXCD, r = nwg % NXCD, xcd = wgid % NXCD, off = wgid / NXCD; wgid = (xcd < r ? xcd * (q + 1) : r * (q + 1) + (xcd - r) * q) + off; }
        const int nig = WGM * nN, gid = wgid / nig, fm = gid * WGM, gsz = (nM - fm) < WGM ? (nM - fm) : WGM;
        u.pm = fm + ((wgid % nig) % gsz); u.pn = (wgid % nig) / gsz; return true;
    }
    __device__ __forceinline__ void a_ready(const Unit&) const {}
    __device__ __forceinline__ void done(const Unit&) const {}
};

__device__ __forceinline__ unsigned cvt_pk_bf16(float lo, float hi) { unsigned r; asm volatile("v_cvt_pk_bf16_f32 %0, %1, %2" : "=v"(r) : "v"(lo), "v"(hi)); return r; }
typedef float f32x2 __attribute__((ext_vector_type(2)));

struct EpiF32 {
    static constexpr bool PERM = false, AFTER_DRAIN = false;
    float* C; int ldc;
    __device__ __forceinline__ void operator()(const f32x4 (&acc)[2][2][4][2], const Unit& u, int wr, int wc, int fr, int fq) const {
        const int row0 = u.pm * BM + wr * 64 + fr, col0 = u.pn * BM + wc * 32 + 4 * fq;
#pragma unroll
        for (int ai = 0; ai < 2; ++ai)
#pragma unroll
            for (int m = 0; m < 4; ++m) { float* rowp = C + (size_t)(row0 + ai * HALF + m * 16) * ldc + col0;
#pragma unroll
                for (int bj = 0; bj < 2; ++bj)
#pragma unroll
                    for (int n = 0; n < 2; ++n) *(f32x4*)(rowp + bj * HALF + n * 16) = acc[ai][bj][m][n]; }
    }
};
struct EpiSwiGLU {
    static constexpr bool PERM = true, AFTER_DRAIN = false;
    bf16_t* O; int ldc;
    __device__ __forceinline__ void operator()(const f32x4 (&acc)[2][2][4][2], const Unit& u, int wr, int wc, int fr, int fq) const {
        const int row0 = u.pm * BM + wr * 64 + fr, col0 = u.pn * HALF + wc * 32 + 8 * fq;
#pragma unroll
        for (int ai = 0; ai < 2; ++ai)
#pragma unroll
            for (int m = 0; m < 4; ++m) {
                float o[8];
#pragma unroll
                for (int n = 0; n < 2; ++n)
#pragma unroll
                    for (int i = 0; i < 4; ++i) { const float a = acc[ai][0][m][n][i], b = acc[ai][1][m][n][i];
                        const float e = __builtin_amdgcn_exp2f(a * -1.4426950408889634f);
                        o[4 * n + i] = (a * b) * __builtin_amdgcn_rcpf(1.0f + e); }
                u32x4 w; w.x = cvt_pk_bf16(o[0], o[1]); w.y = cvt_pk_bf16(o[2], o[3]); w.z = cvt_pk_bf16(o[4], o[5]); w.w = cvt_pk_bf16(o[6], o[7]);
                *(u32x4*)(O + (size_t)(row0 + ai * HALF + m * 16) * ldc + col0) = w; }
    }
};
struct EpiProj {
    static constexpr bool PERM = true, AFTER_DRAIN = false;
    bf16_t* U; bf16_t* QKV;
    __device__ __forceinline__ void operator()(const f32x4 (&acc)[2][2][4][2], const Unit& u, int wr, int wc, int fr, int fq) const {
        const int ct = wc * 32 + 8 * fq;
        if (u.pn < 4) {
            const int row0 = u.pm * BM + wr * 64 + fr;
#pragma unroll
            for (int ai = 0; ai < 2; ++ai)
#pragma unroll
                for (int m = 0; m < 4; ++m) { bf16_t* rowp = U + (size_t)(row0 + ai * HALF + m * 16) * 1024 + u.pn * BM + ct;
#pragma unroll
                    for (int bj = 0; bj < 2; ++bj) { const f32x4 v0 = acc[ai][bj][m][0], v1 = acc[ai][bj][m][1];
                        u32x4 w; w.x = cvt_pk_bf16(v0[0], v0[1]); w.y = cvt_pk_bf16(v0[2], v0[3]); w.z = cvt_pk_bf16(v1[0], v1[1]); w.w = cvt_pk_bf16(v1[2], v1[3]);
                        *(u32x4*)(rowp + bj * HALF) = w; } }
        } else {
            const int t = u.pn - 4, which = t / 12, sl0 = (t % 12) * 2, b = u.pm >> 3, s0 = (u.pm & 7) * BM + wr * 64 + fr;
#pragma unroll
            for (int bj = 0; bj < 2; ++bj) { bf16_t* base = QKV + ((size_t)((which * 4 + b) * 24 + sl0 + bj) * 2048) * 128 + ct;
#pragma unroll
                for (int ai = 0; ai < 2; ++ai)
#pragma unroll
                    for (int m = 0; m < 4; ++m) { const f32x4 v0 = acc[ai][bj][m][0], v1 = acc[ai][bj][m][1];
                        u32x4 w; w.x = cvt_pk_bf16(v0[0], v0[1]); w.y = cvt_pk_bf16(v0[2], v0[3]); w.z = cvt_pk_bf16(v1[0], v1[1]); w.w = cvt_pk_bf16(v1[2], v1[3]);
                        *(u32x4*)(base + (size_t)(s0 + ai * HALF + m * 16) * 128) = w; } }
        }
    }
};
struct EpiBf16P {
    static constexpr bool PERM = true, AFTER_DRAIN = false;
    bf16_t* O; int ldc;
    __device__ __forceinline__ void operator()(const f32x4 (&acc)[2][2][4][2], const Unit& u, int wr, int wc, int fr, int fq) const {
        const int row0 = u.pm * BM + wr * 64 + fr, col0 = u.pn * BM + wc * 32 + 8 * fq;
#pragma unroll
        for (int ai = 0; ai < 2; ++ai)
#pragma unroll
            for (int m = 0; m < 4; ++m) { bf16_t* rowp = O + (size_t)(row0 + ai * HALF + m * 16) * ldc + col0;
#pragma unroll
                for (int bj = 0; bj < 2; ++bj) { const f32x4 v0 = acc[ai][bj][m][0], v1 = acc[ai][bj][m][1];
                    u32x4 w; w.x = cvt_pk_bf16(v0[0], v0[1]); w.y = cvt_pk_bf16(v0[2], v0[3]); w.z = cvt_pk_bf16(v1[0], v1[1]); w.w = cvt_pk_bf16(v1[2], v1[3]);
                    *(u32x4*)(rowp + bj * HALF) = w; } }
    }
};
struct EpiSwiGLU8 {
    static constexpr bool PERM = true, AFTER_DRAIN = false;
    unsigned char* O; int ldc; float scale;
    __device__ __forceinline__ void operator()(const f32x4 (&acc)[2][2][4][2], const Unit& u, int wr, int wc, int fr, int fq) const {
        const int row0 = u.pm * BM + wr * 64 + fr, col0 = u.pn * HALF + wc * 32 + 8 * fq;
#pragma unroll
        for (int ai = 0; ai < 2; ++ai)
#pragma unroll
            for (int m = 0; m < 4; ++m) {
                float o[8];
#pragma unroll
                for (int n = 0; n < 2; ++n)
#pragma unroll
                    for (int i = 0; i < 4; ++i) { const float a = acc[ai][0][m][n][i], b = acc[ai][1][m][n][i];
                        const float e = __builtin_amdgcn_exp2f(a * -1.4426950408889634f);
                        const float v = (a * b) * __builtin_amdgcn_rcpf(1.0f + e) * scale;
                        o[4 * n + i] = __builtin_amdgcn_fmed3f(v, -448.0f, 448.0f); }
                int w0 = __builtin_amdgcn_cvt_pk_fp8_f32(o[0], o[1], 0, false); w0 = __builtin_amdgcn_cvt_pk_fp8_f32(o[2], o[3], w0, true);
                int w1 = __builtin_amdgcn_cvt_pk_fp8_f32(o[4], o[5], 0, false); w1 = __builtin_amdgcn_cvt_pk_fp8_f32(o[6], o[7], w1, true);
                typedef int i32x2 __attribute__((ext_vector_type(2)));
                *(i32x2*)(O + (size_t)(row0 + ai * HALF + m * 16) * ldc + col0) = (i32x2){w0, w1}; }
    }
};
struct EpiBf16S {
    static constexpr bool PERM = true, AFTER_DRAIN = false;
    bf16_t* O; int ldc; float scale;
    __device__ __forceinline__ void operator()(const f32x4 (&acc)[2][2][4][2], const Unit& u, int wr, int wc, int fr, int fq) const {
        const int row0 = u.pm * BM + wr * 64 + fr, col0 = u.pn * BM + wc * 32 + 8 * fq;
#pragma unroll
        for (int ai = 0; ai < 2; ++ai)
#pragma unroll
            for (int m = 0; m < 4; ++m) { bf16_t* rowp = O + (size_t)(row0 + ai * HALF + m * 16) * ldc + col0;
#pragma unroll
                for (int bj = 0; bj < 2; ++bj) { const f32x4 v0 = acc[ai][bj][m][0] * scale, v1 = acc[ai][bj][m][1] * scale;
                    u32x4 w; w.x = cvt_pk_bf16(v0[0], v0[1]); w.y = cvt_pk_bf16(v0[2], v0[3]); w.z = cvt_pk_bf16(v1[0], v1[1]); w.w = cvt_pk_bf16(v1[2], v1[3]);
                    *(u32x4*)(rowp + bj * HALF) = w; } }
    }
};
struct EpiSwiGLUi8 {
    static constexpr bool PERM = true, AFTER_DRAIN = false;
    bf16_t* O; int ldc; const float* sA; const float* amax1; const float* amax3;
    __device__ __forceinline__ void operator()(const f32x4 (&acc)[2][2][4][2], const Unit& u, int wr, int wc, int fr, int fq) const {
        typedef int i32x4e __attribute__((ext_vector_type(4)));
        const int row0 = u.pm * BM + wr * 64 + fr, col0 = u.pn * HALF + wc * 32 + 8 * fq;
        f32x4 s1[2], s3[2];
#pragma unroll
        for (int n = 0; n < 2; ++n) { s1[n] = *(const f32x4*)(amax1 + col0 + 4 * n) * (1.0f / 127.0f); s3[n] = *(const f32x4*)(amax3 + col0 + 4 * n) * (1.0f / 127.0f); }
#pragma unroll
        for (int ai = 0; ai < 2; ++ai)
#pragma unroll
            for (int m = 0; m < 4; ++m) {
                const int row = row0 + ai * HALF + m * 16; const float sa = sA[row];
                float o[8];
#pragma unroll
                for (int n = 0; n < 2; ++n) { const i32x4e i1 = __builtin_bit_cast(i32x4e, acc[ai][0][m][n]), i3 = __builtin_bit_cast(i32x4e, acc[ai][1][m][n]);
#pragma unroll
                    for (int i = 0; i < 4; ++i) { const float a = (float)i1[i] * (sa * s1[n][i]), b = (float)i3[i] * (sa * s3[n][i]);
                        const float e = __builtin_amdgcn_exp2f(a * -1.4426950408889634f);
                        o[4 * n + i] = (a * b) * __builtin_amdgcn_rcpf(1.0f + e); } }
                u32x4 w; w.x = cvt_pk_bf16(o[0], o[1]); w.y = cvt_pk_bf16(o[2], o[3]); w.z = cvt_pk_bf16(o[4], o[5]); w.w = cvt_pk_bf16(o[6], o[7]);
                *(u32x4*)(O + (size_t)row * ldc + col0) = w; }
    }
};
typedef int i32x8 __attribute__((ext_vector_type(8)));
typedef int i32x4v __attribute__((ext_vector_type(4)));
__device__ __forceinline__ i32x8 pg8_cat(bf16x8 lo, bf16x8 hi) { const i32x4v a = __builtin_bit_cast(i32x4v, lo), b = __builtin_bit_cast(i32x4v, hi); return __builtin_shufflevector(a, b, 0, 1, 2, 3, 4, 5, 6, 7); }
template <class Epi, class Sched, bool ALIGN_EPI = false, bool SP2 = false, int MODE = 0, int AUXA = 0, int AUXB = 0>
__device__ __forceinline__ void gemm_phase(PG8_LAS unsigned char* lds, const Gemm g, const Sched& S, const Epi& E, const int tid_in) {
    const int tid = tid_in, wid = __builtin_amdgcn_readfirstlane(tid >> 6), lane = tid & 63, wr = wid >> 2, wc = wid & 3, fr = lane & 15, fq = lane >> 4;
    const int K = g.K, nt = MODE ? K / 128 : K / BK;
    const int sc1 = 0x7f7f7f7f;
    unsigned voffA[2], voffB[2];
#pragma unroll
    for (int i = 0; i < 2; ++i) { int R, C; stage_rc(tid * 16 + i * 8192, R, C); const int Rb = Epi::PERM ? ((R & ~31) + perm32(R & 31)) : R;
        if constexpr (MODE == 1) { const int Cs = 16 * (2 * ((C >> 3) & 3) + (C >> 5));
            voffA[i] = (unsigned)(R * K + Cs); voffB[i] = (unsigned)(Rb * K + Cs); }
        else if constexpr (MODE == 2) { voffA[i] = (unsigned)(R * K + 2 * C); voffB[i] = (unsigned)(Rb * K + 2 * C); }
        else { voffA[i] = (unsigned)(R * K + C) * 2u; voffB[i] = (unsigned)(Rb * K + C) * 2u; } }
    const size_t kstep = (size_t)(BK * 2);
    const size_t hstep = (size_t)HALF * K * (MODE ? 1 : 2);
    const size_t tstep = 2 * hstep;
    const unsigned ldsw = (unsigned)wid * 1024u;
    const int aoff = lds_byte(wr * 64 + fr, fq * 8), boff = lds_byte(wc * 32 + fr, fq * 8);
#define PG8_SA(b, h) (((b) * 2 + (h)) * HTB)
#define PG8_SB(b, h) ((4 + (b) * 2 + (h)) * HTB)
    constexpr int PG8_AUX_voffA = AUXA, PG8_AUX_voffB = AUXB;
#define PG8_STAGE(bufoff, gbase, voff) do { _Pragma("unroll") for (int _i = 0; _i < 2; ++_i) \
        __builtin_amdgcn_global_load_lds((const unsigned*)((const char*)(gbase) + (voff)[_i]), (PG8_LAS unsigned*)(lds + (bufoff) + ldsw + _i * 8192), 16, 0, PG8_AUX_##voff); } while (0)
#define PG8_LDA(dst, b, h) do { _Pragma("unroll") for (int m = 0; m < 4; ++m) _Pragma("unroll") for (int k = 0; k < 2; ++k) dst[m][k] = *(const PG8_LAS bf16x8*)(lds + PG8_SA(b, h) + aoff + m * 2048 + k * 1024); } while (0)
#define PG8_LDB(dst, b, h) do { _Pragma("unroll") for (int n = 0; n < 2; ++n) _Pragma("unroll") for (int k = 0; k < 2; ++k) dst[n][k] = *(const PG8_LAS bf16x8*)(lds + PG8_SB(b, h) + boff + n * 2048 + k * 1024); } while (0)
#define PG8_MMA(ai, bj, At, Bt) do { __builtin_amdgcn_s_setprio(1); if constexpr (MODE == 1) { _Pragma("unroll") for (int m = 0; m < 4; ++m) _Pragma("unroll") for (int n = 0; n < 2; ++n) { \
        const i32x8 a8_ = pg8_cat(Bt[n][0], Bt[n][1]), b8_ = pg8_cat(At[m][0], At[m][1]); \
        asm volatile("v_mfma_scale_f32_16x16x128_f8f6f4 %0, %1, %2, %0, %3, %3 op_sel_hi:[0,0,0]" : "+v"(acc[ai][bj][m][n]) : "v"(a8_), "v"(b8_), "v"(sc1)); } } \
        else if constexpr (MODE == 2) { _Pragma("unroll") for (int m = 0; m < 4; ++m) _Pragma("unroll") for (int n = 0; n < 2; ++n) _Pragma("unroll") for (int k = 0; k < 2; ++k) \
        acc[ai][bj][m][n] = __builtin_bit_cast(f32x4, __builtin_amdgcn_mfma_i32_16x16x64_i8(__builtin_bit_cast(i32x4v, Bt[n][k]), __builtin_bit_cast(i32x4v, At[m][k]), __builtin_bit_cast(i32x4v, acc[ai][bj][m][n]), 0, 0, 0)); } \
        else { _Pragma("unroll") for (int m = 0; m < 4; ++m) _Pragma("unroll") for (int n = 0; n < 2; ++n) _Pragma("unroll") for (int k = 0; k < 2; ++k) \
        acc[ai][bj][m][n] = __builtin_amdgcn_mfma_f32_16x16x32_bf16(Bt[n][k], At[m][k], acc[ai][bj][m][n], 0, 0, 0); } __builtin_amdgcn_s_setprio(0); } while (0)
#define PG8_WAIT_V(n) asm volatile("s_waitcnt vmcnt(" #n ")" ::: "memory")
#define PG8_WAIT_L(n) asm volatile("s_waitcnt lgkmcnt(" #n ")" ::: "memory")
#define PG8_BAR __builtin_amdgcn_s_barrier()
#define PG8_SCHED __builtin_amdgcn_sched_barrier(0)
    Unit cur, nxt; int ui = 0;
    if (!S.next(0, cur)) return;
    f32x4 acc[2][2][4][2];
#pragma unroll
    for (int a = 0; a < 2; ++a)
#pragma unroll
        for (int b = 0; b < 2; ++b)
#pragma unroll
            for (int m = 0; m < 4; ++m)
#pragma unroll
                for (int n = 0; n < 2; ++n) acc[a][b][m][n] = (f32x4){0.f, 0.f, 0.f, 0.f};
    bf16x8 At[4][2], B0[2][2], B1[2][2];
    const char* cA = (const char*)g.A + (size_t)cur.pm * tstep; const char* cB = (const char*)g.Bt + (size_t)cur.pn * tstep;
    S.a_ready(cur);
    if constexpr (SP2) {
        PG8_STAGE(PG8_SB(0, 0), cB, voffB); PG8_STAGE(PG8_SB(0, 1), cB + hstep, voffB); PG8_STAGE(PG8_SA(0, 0), cA, voffA); PG8_STAGE(PG8_SA(0, 1), cA + hstep, voffA);
        if (wr == 1) PG8_BAR;
        PG8_WAIT_V(2); PG8_BAR;
        PG8_STAGE(PG8_SB(1, 0), cB + kstep, voffB); PG8_STAGE(PG8_SA(1, 0), cA + kstep, voffA); PG8_STAGE(PG8_SB(1, 1), cB + hstep + kstep, voffB);
        PG8_WAIT_V(6); PG8_BAR;
    } else {
        PG8_STAGE(PG8_SB(0, 0), cB, voffB); PG8_STAGE(PG8_SA(0, 0), cA, voffA); PG8_STAGE(PG8_SB(0, 1), cB + hstep, voffB); PG8_STAGE(PG8_SA(0, 1), cA + hstep, voffA);
        if (wr == 1) PG8_BAR;
        PG8_WAIT_V(4); PG8_BAR;
        PG8_STAGE(PG8_SB(1, 0), cB + kstep, voffB); PG8_STAGE(PG8_SA(1, 0), cA + kstep, voffA); PG8_STAGE(PG8_SB(1, 1), cB + hstep + kstep, voffB);
        PG8_WAIT_V(6); PG8_BAR;
    }
    for (;;) {
        const bool has_next = S.next(ui + 1, nxt);
        const char* nA = has_next ? (const char*)g.A + (size_t)nxt.pm * tstep : cA; const char* nB = has_next ? (const char*)g.Bt + (size_t)nxt.pn * tstep : cB;
        for (int t = 0; t < nt; t += 2) {
            const bool last = (t == nt - 2);
            const char* a1 = cA + (size_t)(t + 1) * kstep;
            const char* a2 = last ? nA : cA + (size_t)(t + 2) * kstep; const char* b2 = last ? nB : cB + (size_t)(t + 2) * kstep;
            const char* a3 = a2 + kstep; const char* b3 = b2 + kstep;
            if (last && has_next) S.a_ready(nxt);
            if constexpr (SP2) {
            PG8_LDB(B0, 0, 0); PG8_LDB(B1, 0, 1); PG8_SCHED; PG8_LDA(At, 0, 0); PG8_STAGE(PG8_SA(1, 1), a1 + hstep, voffA);
            PG8_WAIT_V(8); PG8_WAIT_L(0); PG8_BAR; PG8_MMA(0, 0, At, B0); PG8_MMA(0, 1, At, B1); PG8_BAR; PG8_SCHED;
            PG8_LDA(At, 0, 1); PG8_STAGE(PG8_SB(0, 0), b2, voffB); PG8_STAGE(PG8_SB(0, 1), b2 + hstep, voffB); PG8_STAGE(PG8_SA(0, 0), a2, voffA);
            PG8_WAIT_V(8); PG8_WAIT_L(0); PG8_BAR; PG8_MMA(1, 0, At, B0); PG8_MMA(1, 1, At, B1); PG8_BAR; PG8_SCHED;
            PG8_LDB(B0, 1, 0); PG8_LDB(B1, 1, 1); PG8_SCHED; PG8_LDA(At, 1, 0); PG8_STAGE(PG8_SA(0, 1), a2 + hstep, voffA);
            PG8_WAIT_V(8); PG8_WAIT_L(0); PG8_BAR; PG8_MMA(0, 0, At, B0); PG8_MMA(0, 1, At, B1); PG8_BAR; PG8_SCHED;
            PG8_LDA(At, 1, 1); PG8_STAGE(PG8_SB(1, 0), b3, voffB); PG8_STAGE(PG8_SB(1, 1), b3 + hstep, voffB); PG8_STAGE(PG8_SA(1, 0), a3, voffA);
            PG8_WAIT_V(8); PG8_WAIT_L(0); PG8_BAR; PG8_MMA(1, 0, At, B0); PG8_MMA(1, 1, At, B1); PG8_BAR; PG8_SCHED;
            } else {
            PG8_LDB(B0, 0, 0); PG8_SCHED; PG8_LDA(At, 0, 0); PG8_STAGE(PG8_SA(1, 1), a1 + hstep, voffA);
            PG8_WAIT_L(8); PG8_BAR; PG8_WAIT_L(0); PG8_MMA(0, 0, At, B0); PG8_BAR; PG8_SCHED;
            PG8_LDB(B1, 0, 1); PG8_STAGE(PG8_SB(0, 0), b2, voffB);
            PG8_BAR; PG8_WAIT_L(0); PG8_MMA(0, 1, At, B1); PG8_BAR;
            PG8_LDA(At, 0, 1); PG8_STAGE(PG8_SA(0, 0), a2, voffA);
            PG8_BAR; PG8_WAIT_L(0); PG8_MMA(1, 0, At, B0); PG8_BAR; PG8_SCHED;
            PG8_STAGE(PG8_SB(0, 1), b2 + hstep, voffB);
            PG8_WAIT_V(6); PG8_BAR; PG8_MMA(1, 1, At, B1); PG8_BAR;
            PG8_LDB(B0, 1, 0); PG8_SCHED; PG8_LDA(At, 1, 0); PG8_STAGE(PG8_SA(0, 1), a2 + hstep, voffA);
            PG8_WAIT_L(8); PG8_BAR; PG8_WAIT_L(0); PG8_MMA(0, 0, At, B0); PG8_BAR; PG8_SCHED;
            PG8_LDB(B1, 1, 1); PG8_STAGE(PG8_SB(1, 0), b3, voffB);
            PG8_BAR; PG8_WAIT_L(0); PG8_MMA(0, 1, At, B1); PG8_BAR;
            PG8_LDA(At, 1, 1); PG8_STAGE(PG8_SA(1, 0), a3, voffA);
            PG8_BAR; PG8_WAIT_L(0); PG8_MMA(1, 0, At, B0); PG8_BAR; PG8_SCHED;
            PG8_STAGE(PG8_SB(1, 1), b3 + hstep, voffB);
            PG8_WAIT_V(6); PG8_BAR; PG8_MMA(1, 1, At, B1); PG8_BAR;
            }
        }
        if constexpr (ALIGN_EPI) { if (wr == 0) PG8_BAR; }
        if constexpr (MODE == 1) { asm volatile("s_nop 15\n\ts_nop 15\n\ts_nop 15" : "+v"(acc[1][1][0][0]), "+v"(acc[1][1][0][1]), "+v"(acc[1][1][1][0]), "+v"(acc[1][1][1][1]), "+v"(acc[1][1][2][0]), "+v"(acc[1][1][2][1]), "+v"(acc[1][1][3][0]), "+v"(acc[1][1][3][1])); }
        if constexpr (!Epi::AFTER_DRAIN) { E(acc, cur, wr, wc, fr, fq); S.done(cur); }
        if (!has_next) break;
#pragma unroll
        for (int a = 0; a < 2; ++a)
#pragma unroll
            for (int b = 0; b < 2; ++b)
#pragma unroll
                for (int m = 0; m < 4; ++m)
#pragma unroll
                    for (int n = 0; n < 2; ++n) acc[a][b][m][n] = (f32x4){0.f, 0.f, 0.f, 0.f};
        cur = nxt; cA = nA; cB = nB; ++ui;
        if constexpr (ALIGN_EPI) { if (wr == 1) PG8_BAR; }
    }
    PG8_WAIT_V(0);
    if constexpr (!ALIGN_EPI) { if (wr == 0) PG8_BAR; }
    PG8_BAR;
    if constexpr (Epi::AFTER_DRAIN) { E.fused(acc, cur, wr, wc, fr, fq, lds, wid, lane); S.done(cur); }
#undef PG8_SA
#undef PG8_SB
#undef PG8_STAGE
#undef PG8_LDA
#undef PG8_LDB
#undef PG8_MMA
#undef PG8_WAIT_V
#undef PG8_WAIT_L
#undef PG8_BAR
#undef PG8_SCHED
}
}

namespace attn {
constexpr int D = 128;
constexpr float THR = 8.f;
constexpr bool WSKIP = false;
constexpr float SCALE = 0.08838834764831845f;
constexpr int NW = 8, QBLK = 32, KVBLK = 64, QB = NW * QBLK;
constexpr int SHM_V = KVBLK * D * 2, SHM_K = KVBLK * D * 2;
constexpr int LDS_BYTES = 2 * SHM_V + 2 * SHM_K + NW * 64 * 4;

using bf16 = __hip_bfloat16;
typedef short bf16x8 __attribute__((ext_vector_type(8)));
typedef short s16x4 __attribute__((ext_vector_type(4)));
typedef float f32x16 __attribute__((ext_vector_type(16)));
typedef float f32x4 __attribute__((ext_vector_type(4)));
typedef unsigned u32x4 __attribute__((ext_vector_type(4)));
template <class A, class Bt> struct same_t { static constexpr bool v = false; };
template <class A> struct same_t<A, A> { static constexpr bool v = true; };

#define KSWZ(row, colB) ((row) * 256 + ((colB) ^ (((row) & 7) << 4)))
#define SBAR() __builtin_amdgcn_sched_barrier(0)
__device__ __forceinline__ int v_st(int k, int c) { const int kk = (k & ~0xC) | ((k & 4) << 1) | ((k & 8) >> 1); return ((kk >> 3) * 4 + (c >> 5)) * 512 + ((kk & 7) * 32 + (c & 31)) * 2; }
__device__ __forceinline__ int v_rd_base(int lane) { return ((lane & 3) << 3) | (((lane >> 2) & 3) << 6) | (((lane >> 4) & 1) << 5) | (((lane >> 5) & 1) << 8); }
constexpr int v_rd_off(int d0, int ks, int half) { return d0 * 512 + ks * 4096 + half * 2048; }
__device__ __forceinline__ int crow(int r, int hi) { return (r & 3) + 8 * (r >> 2) + 4 * hi; }
__device__ __forceinline__ unsigned cvtpk(float lo, float hi) {
    unsigned r; asm volatile("v_cvt_pk_bf16_f32 %0, %1, %2" : "=v"(r) : "v"(lo), "v"(hi)); return r;
}
__device__ __forceinline__ bf16x8 pack8(f32x4 a, f32x4 b) {
    u32x4 w = {cvtpk(a[0], a[1]), cvtpk(a[2], a[3]), cvtpk(b[0], b[1]), cvtpk(b[2], b[3])};
    return *reinterpret_cast<bf16x8*>(&w);
}
template <class T> __device__ __forceinline__ bf16x8 load8(const T* p) {
    if constexpr (same_t<T, float>::v) { return pack8(*(const f32x4*)p, *(const f32x4*)(p + 4)); }
    else { return *reinterpret_cast<const bf16x8*>(p); }
}
__device__ __forceinline__ void mask_tile(f32x16& p0, f32x16& p1, int dq, unsigned W) {
    const float NEG = -__builtin_inff();
#pragma unroll
    for (int r = 0; r < 16; ++r) {
        const int c = (r & 3) + 8 * (r >> 2);
        if ((unsigned)(dq - c) >= W) p0[r] = NEG;
        if ((unsigned)(dq - c - 32) >= W) p1[r] = NEG;
    }
}
__device__ __forceinline__ void partialSM(f32x16& p0, f32x16& p1, float& m_reg, float& mn, float& alpha) {
    float pmax = p0[0]; for (int r = 1; r < 16; ++r) pmax = fmaxf(pmax, p0[r]); for (int r = 0; r < 16; ++r) pmax = fmaxf(pmax, p1[r]);
    { auto rr = __builtin_amdgcn_permlane32_swap(__float_as_uint(pmax), __float_as_uint(pmax), false, false);
      pmax = fmaxf(__uint_as_float(rr[0]), __uint_as_float(rr[1])); }
    constexpr float C2 = 1.4426950408889634f * SCALE;
    if (__builtin_expect(__all((pmax - m_reg) * SCALE <= THR), 1)) { mn = m_reg; alpha = 1.f; }
    else { mn = fmaxf(m_reg, pmax); alpha = __builtin_amdgcn_exp2f((m_reg - mn) * C2); m_reg = mn; }
    const float mnL = -mn * C2;
    for (int r = 0; r < 16; ++r) p0[r] = fmaf(p0[r], C2, mnL); for (int r = 0; r < 16; ++r) p1[r] = fmaf(p1[r], C2, mnL);
    for (int r = 0; r < 16; ++r) p0[r] = __builtin_amdgcn_exp2f(p0[r]);
}
__device__ __forceinline__ void finishSM(f32x16& p0, f32x16& p1, float alpha, float& l_reg, bf16x8& pa0, bf16x8& pa1, bf16x8& pa2, bf16x8& pa3) {
    for (int r = 0; r < 16; ++r) p1[r] = __builtin_amdgcn_exp2f(p1[r]);
    float ps = 0; for (int r = 0; r < 16; ++r) ps += p0[r]; for (int r = 0; r < 16; ++r) ps += p1[r];
    { auto rr = __builtin_amdgcn_permlane32_swap(__float_as_uint(ps), __float_as_uint(ps), false, false);
      ps = __uint_as_float(rr[0]) + __uint_as_float(rr[1]); }
    l_reg = l_reg * alpha + ps;
#define PK4(P, B_, OUT) do { unsigned a0 = cvtpk(P[B_+0], P[B_+1]), a1 = cvtpk(P[B_+2], P[B_+3]);                          \
        unsigned b0 = cvtpk(P[B_+4], P[B_+5]), b1 = cvtpk(P[B_+6], P[B_+7]);                                             \
        auto r0 = __builtin_amdgcn_permlane32_swap(a0, b0, false, false); auto r1 = __builtin_amdgcn_permlane32_swap(a1, b1, false, false); \
        u32x4 w = {r0[0], r1[0], r0[1], r1[1]}; OUT = *reinterpret_cast<bf16x8*>(&w); } while (0)
    PK4(p0, 0, pa0); PK4(p0, 8, pa1); PK4(p1, 0, pa2); PK4(p1, 8, pa3);
#undef PK4
}
template <int KB, bool SK>
__device__ __forceinline__ void qkt(f32x16& p0, f32x16& p1, const char* K_lds, int r32, int hi, const bf16x8* qr, bool act) {
    if (SK && !act) { const float NEG = -__builtin_inff();
#pragma unroll
        for (int r = 0; r < 16; ++r) { p0[r] = NEG; p1[r] = NEG; } return; }
    p0 = f32x16{}; p1 = f32x16{};
    const char* kb[4];
#pragma unroll
    for (int dd = 0; dd < 4; ++dd) kb[dd] = K_lds + KB * SHM_K + KSWZ(r32, (dd * 16 + hi * 8) * 2);
#pragma unroll
    for (int d0 = 0; d0 < 8; ++d0) { const char* a = kb[d0 & 3] + (d0 >> 2) * 128;
        bf16x8 b0 = *reinterpret_cast<const bf16x8*>(a);
        bf16x8 b1 = *reinterpret_cast<const bf16x8*>(a + 32 * 256);
        p0 = __builtin_amdgcn_mfma_f32_32x32x16_bf16(b0, qr[d0], p0, 0, 0, 0);
        p1 = __builtin_amdgcn_mfma_f32_32x32x16_bf16(b1, qr[d0], p1, 0, 0, 0); }
}
template <int VB, bool SK>
__device__ __forceinline__ void pv_tile(f32x16* o, int vb0, bf16x8 pa0, bf16x8 pa1, bf16x8 pa2, bf16x8 pa3, bool act) {
    if (SK && !act) return;
#define TRRD(dst, off) asm volatile("ds_read_b64_tr_b16 %0, %1 offset:%2" : "=&v"(dst) : "v"(vb0), "i"(off) : "memory")
#define PV_D0(d0) do { s16x4 l0, l1, l2, l3, h0, h1, h2, h3; constexpr int b_ = VB * SHM_V + v_rd_off(d0, 0, 0);     \
        TRRD(l0, b_); TRRD(h0, b_ + 2048); TRRD(l1, b_ + 4096); TRRD(h1, b_ + 6144); TRRD(l2, b_ + 8192); TRRD(h2, b_ + 10240); TRRD(l3, b_ + 12288); TRRD(h3, b_ + 14336); \
        asm volatile("s_waitcnt lgkmcnt(0)" ::: "memory"); SBAR();                 \
        o[d0] = __builtin_amdgcn_mfma_f32_32x32x16_bf16(pa0, (bf16x8){l0[0], l0[1], l0[2], l0[3], h0[0], h0[1], h0[2], h0[3]}, o[d0], 0, 0, 0);   \
        o[d0] = __builtin_amdgcn_mfma_f32_32x32x16_bf16(pa1, (bf16x8){l1[0], l1[1], l1[2], l1[3], h1[0], h1[1], h1[2], h1[3]}, o[d0], 0, 0, 0);   \
        o[d0] = __builtin_amdgcn_mfma_f32_32x32x16_bf16(pa2, (bf16x8){l2[0], l2[1], l2[2], l2[3], h2[0], h2[1], h2[2], h2[3]}, o[d0], 0, 0, 0);   \
        o[d0] = __builtin_amdgcn_mfma_f32_32x32x16_bf16(pa3, (bf16x8){l3[0], l3[1], l3[2], l3[3], h3[0], h3[1], h3[2], h3[3]}, o[d0], 0, 0, 0); } while (0)
    PV_D0(0); PV_D0(1); PV_D0(2); PV_D0(3);
#undef PV_D0
#undef TRRD
}

template <class TIn, class TOut> struct BlockRef { const TIn* Q; const TIn* K; const TIn* V; TOut* O; int P0; };
template <class TIn> struct Seam {
    bf16x8 qr[8];
    bf16x8 st_v0, st_v1, st_k0, st_k1; f32x4 sf0, sf1, sf2, sf3;
    f32x4 tq[16];
};
__device__ __forceinline__ int swa_jlo(int P0, int W) { const int lowk = P0 - W + 1; return lowk > 0 ? lowk / KVBLK : 0; }
#define ROW(p, k0, rr) ((p) + (size_t)((k0) + (rr)) * D + sc)
#define VMW() asm volatile("s_waitcnt vmcnt(0)" ::: "memory")
#define VMWN(n) asm volatile("s_waitcnt vmcnt(%0)" :: "i"(n) : "memory")
#define SLOAD_H(Kp, Vp, k0) do { S.st_v0 = load8<TIn>(ROW(Vp, k0, sr)); S.st_v1 = load8<TIn>(ROW(Vp, k0, 32 + sr));              \
                         S.st_k0 = load8<TIn>(ROW(Kp, k0, sr)); S.st_k1 = load8<TIn>(ROW(Kp, k0, 32 + sr)); } while (0)
#define SWRITE_HK(bf) do { *(bf16x8*)(K_lds + (bf) * SHM_K + kws) = S.st_k0; *(bf16x8*)(K_lds + (bf) * SHM_K + kws + 32 * 256) = S.st_k1; } while (0)
#define SWRITE_HV(bf) do { *(bf16x8*)(V_lds + (bf) * SHM_V + vst0) = S.st_v0; *(bf16x8*)(V_lds + (bf) * SHM_V + vst1) = S.st_v1; } while (0)
#define SWRITE_H(bf) do { SWRITE_HV(bf); SWRITE_HK(bf); } while (0)
#define SLOAD_F(p, k0) do { S.sf0 = *(const f32x4*)ROW(p, k0, sr); S.sf1 = *(const f32x4*)(ROW(p, k0, sr) + 4);                \
                            S.sf2 = *(const f32x4*)ROW(p, k0, 32 + sr); S.sf3 = *(const f32x4*)(ROW(p, k0, 32 + sr) + 4); } while (0)
#define SWRITE_KF(bf) do { *(bf16x8*)(K_lds + (bf) * SHM_K + kws) = pack8(S.sf0, S.sf1); *(bf16x8*)(K_lds + (bf) * SHM_K + kws + 32 * 256) = pack8(S.sf2, S.sf3); } while (0)
#define SWRITE_VF(bf) do { *(bf16x8*)(V_lds + (bf) * SHM_V + vst0) = pack8(S.sf0, S.sf1); *(bf16x8*)(V_lds + (bf) * SHM_V + vst1) = pack8(S.sf2, S.sf3); } while (0)
template <class TIn, class TOut>
__device__ __forceinline__ void causal_swa_prime(const BlockRef<TIn, TOut>& cur, int W, char* lds, Seam<TIn>& S, const int tid_in) {
    constexpr bool F32 = same_t<TIn, float>::v;
    const int tid = tid_in, wid = __builtin_amdgcn_readfirstlane(tid >> 6), lane = tid & 63, r32 = lane & 31, hi = lane >> 5;
    const int sr = tid >> 4, sc = (tid & 15) * 8, kws = KSWZ(sr, sc * 2); char* K_lds = lds + 2 * SHM_V;
    const int kb0 = swa_jlo(cur.P0, W) * KVBLK;
    for (int d0 = 0; d0 < 8; ++d0) S.qr[d0] = load8<TIn>(cur.Q + (size_t)(wid * QBLK + r32) * D + d0 * 16 + hi * 8);
    if constexpr (F32) { SLOAD_F((const float*)cur.K, kb0); VMW(); SWRITE_KF(0); SBAR(); SLOAD_F((const float*)cur.V, kb0); }
    else { SLOAD_H(cur.K, cur.V, kb0); VMW(); SWRITE_HK(0); }
    __syncthreads();
}
template <class TIn, class TOut>
__device__ __forceinline__ void causal_swa_block(const BlockRef<TIn, TOut>& cur, const BlockRef<TIn, TOut>& nxt, int skv, int W, char* lds, Seam<TIn>& S, const int tid_in) {
    constexpr bool F32 = same_t<TIn, float>::v;
    const int tid = tid_in, wid = __builtin_amdgcn_readfirstlane(tid >> 6), lane = tid & 63, r32 = lane & 31, hi = lane >> 5;
    const int j_lo = swa_jlo(cur.P0, W);
    int j_hi = (cur.P0 + QB - 1) / KVBLK + 1; if (j_hi > skv / KVBLK) j_hi = skv / KVBLK;
    const int NT = j_hi - j_lo;
    const int kbn = swa_jlo(nxt.P0, W) * KVBLK;
    const int qlo = cur.P0 + wid * QBLK, qm = qlo + r32 - 4 * hi;
    char* V_lds = lds; char* K_lds = lds + 2 * SHM_V;
    float* ws = (float*)(lds + 2 * SHM_V + 2 * SHM_K) + wid * 64; float* li_l = ws, * al_l = ws + 32;
    float m_reg = -1e30f, l_reg = 0; f32x16 o[4] = {};
    const int sr = tid >> 4, sc = (tid & 15) * 8, vst0 = v_st(sr, sc), vst1 = v_st(32 + sr, sc), kws = KSWZ(sr, sc * 2);
    const int vb0 = (int)(uintptr_t)V_lds + v_rd_base(lane);
    const TIn* Kh = cur.K; const TIn* Vh = cur.V;
#define RESC(a) do { if (__any((a) < 1.f)) { if (hi == 0) al_l[r32] = (a); asm volatile("s_waitcnt lgkmcnt(0)" ::: "memory");              \
                     for (int d_ = 0; d_ < 4; ++d_) for (int r = 0; r < 16; ++r) o[d_][r] *= al_l[crow(r, hi)]; } } while (0)
#define KBASE(t) ((j_lo + (t)) * KVBLK)
#define ACT(t) (KBASE(t) <= qlo + QBLK - 1 && KBASE(t) + KVBLK - 1 >= qlo - W + 1)
#define MASKT(P0_, P1_, t) do { const int kb_ = KBASE(t); if ((!SK || ACT(t)) && (kb_ + KVBLK - 1 > qlo || kb_ <= qlo + QBLK - 1 - W)) mask_tile(P0_, P1_, qm - kb_, (unsigned)W); } while (0)
    constexpr int NQL = F32 ? 16 : 8;
    constexpr bool SK = WSKIP && !F32;
#define SEAM_K0() do { VMWN(NQL); if constexpr (F32) { SWRITE_KF(0); SBAR(); SLOAD_F((const float*)nxt.V, kbn); } else { SWRITE_HK(0); } SBAR(); } while (0)
    f32x16 pA0, pA1, pB0, pB1; float mnA, mnB, alA, alB; bf16x8 pa0, pa1, pa2, pa3;
    if constexpr (F32) { VMW(); SWRITE_VF(0); SBAR(); } else { SWRITE_HV(0); SBAR(); }
    if (NT > 1) { if constexpr (F32) SLOAD_F((const float*)Kh, KBASE(1)); else SLOAD_H(Kh, Vh, KBASE(1)); }
    SBAR(); qkt<0, SK>(pA0, pA1, K_lds, r32, hi, S.qr, ACT(0));
    if constexpr (F32) { if (NT > 1) { VMW(); SWRITE_KF(1); SBAR(); SLOAD_F((const float*)Vh, KBASE(1)); } }
    MASKT(pA0, pA1, 0); partialSM(pA0, pA1, m_reg, mnA, alA);
    if (NT > 1) { VMW(); if constexpr (F32) { SWRITE_VF(1); SBAR(); if (NT > 2) SLOAD_F((const float*)Kh, KBASE(2)); } else SWRITE_H(1); }
    __syncthreads();
#define HALF_STEP(PX0, PX1, mnX, alX, PY0, PY1, alY, t, KB, VB, SB) do {                                                      \
        SBAR(); qkt<KB, SK>(PX0, PX1, K_lds, r32, hi, S.qr, ACT(t));                                             \
        finishSM(PY0, PY1, alY, l_reg, pa0, pa1, pa2, pa3); SBAR();                                                           \
        if ((t) + 1 < NT) { if constexpr (F32) { VMW(); SWRITE_KF(SB); SBAR(); SLOAD_F((const float*)Vh, KBASE((t) + 1)); }  \
                            else { SLOAD_H(Kh, Vh, KBASE((t) + 1)); } SBAR(); }                                               \
        pv_tile<VB, SK>(o, vb0, pa0, pa1, pa2, pa3, ACT((t) - 1)); MASKT(PX0, PX1, (t)); partialSM(PX0, PX1, m_reg, mnX, alX);                                        \
        __syncthreads();                                                                                                      \
        if ((t) + 1 < NT) { VMW(); if constexpr (F32) { SWRITE_VF(SB); SBAR(); if ((t) + 2 < NT) SLOAD_F((const float*)Kh, KBASE((t) + 2)); } \
                            else { SWRITE_H(SB); } }                                                                          \
        RESC(alX); __syncthreads(); } while (0)
    for (int t = 1; t + 1 < NT; t += 2) {
        HALF_STEP(pB0, pB1, mnB, alB, pA0, pA1, alA, t, 1, 0, 0);
        HALF_STEP(pA0, pA1, mnA, alA, pB0, pB1, alB, t + 1, 0, 1, 1);
    }
    const bool even = (NT & 1) == 0;
    if (even) { SBAR(); qkt<1, SK>(pB0, pB1, K_lds, r32, hi, S.qr, ACT(NT - 1)); SBAR(); }
#define QROW(e) (nxt.Q + (size_t)(wid * QBLK + r32) * D + ((e) >> 1) * 16 + hi * 8 + ((e) & 1) * 4)
    if constexpr (F32) { SLOAD_F((const float*)nxt.K, kbn); SBAR();
#pragma unroll
        for (int e = 0; e < 8; ++e) S.tq[e] = *(const f32x4*)QROW(e); }
    else { SLOAD_H(nxt.K, nxt.V, kbn); SBAR();
#pragma unroll
        for (int d0 = 0; d0 < 8; ++d0) S.qr[d0] = load8<TIn>(nxt.Q + (size_t)(wid * QBLK + r32) * D + d0 * 16 + hi * 8); }
    SBAR();
    finishSM(pA0, pA1, alA, l_reg, pa0, pa1, pa2, pa3); SBAR();
    if constexpr (F32) {
#pragma unroll
        for (int e = 8; e < 16; ++e) S.tq[e] = *(const f32x4*)QROW(e); SBAR(); }
#undef QROW
    pv_tile<0, SK>(o, vb0, pa0, pa1, pa2, pa3, ACT(even ? NT - 2 : NT - 1));
    if (even) { MASKT(pB0, pB1, NT - 1); partialSM(pB0, pB1, m_reg, mnB, alB); __syncthreads(); RESC(alB);
        finishSM(pB0, pB1, alB, l_reg, pa0, pa1, pa2, pa3); SBAR(); pv_tile<1, SK>(o, vb0, pa0, pa1, pa2, pa3, ACT(NT - 1)); }
    SBAR(); SEAM_K0();
    if (hi == 0) li_l[r32] = l_reg; asm volatile("s_waitcnt lgkmcnt(0)" ::: "memory");
    float rli[16];
#pragma unroll
    for (int r = 0; r < 16; ++r) rli[r] = __builtin_amdgcn_rcpf(li_l[crow(r, hi)]);
    TOut* Ow = cur.O + (size_t)(wid * QBLK) * D;
#pragma unroll
    for (int r = 0; r < 16; ++r) { const int orow = crow(r, hi);
#pragma unroll
        for (int d0 = 0; d0 < 4; ++d0) { const float v = o[d0][r] * rli[r];
            if constexpr (same_t<TOut, float>::v) { Ow[(size_t)orow * D + d0 * 32 + r32] = v; }
            else { const float vn = __shfl_xor(v, 1);
                   if ((r32 & 1) == 0) *(unsigned*)(Ow + (size_t)orow * D + d0 * 32 + r32) = cvtpk(v, vn); } } }
    if constexpr (F32) {
#pragma unroll
        for (int d0 = 0; d0 < 8; ++d0) S.qr[d0] = pack8(S.tq[2 * d0], S.tq[2 * d0 + 1]); }
    __syncthreads();
#undef RESC
#undef KBASE
#undef ACT
#undef MASKT
#undef SEAM_K0
#undef HALF_STEP
}
#undef ROW
#undef VMW
#undef VMWN
#undef SLOAD_H
#undef SWRITE_HK
#undef SWRITE_HV
#undef SWRITE_H
#undef SLOAD_F
#undef SWRITE_KF
#undef SWRITE_VF
}

namespace attx {
typedef short bf16x8 __attribute__((ext_vector_type(8)));
typedef short s16x4 __attribute__((ext_vector_type(4)));
typedef float f32x4 __attribute__((ext_vector_type(4)));
typedef unsigned u32x2 __attribute__((ext_vector_type(2)));
typedef unsigned u32x4 __attribute__((ext_vector_type(4)));
#define AX_LAS __attribute__((address_space(3)))
constexpr int SEQ = 2048, STAGE_BYTES = 49152, LDS_BYTES = 2 * STAGE_BYTES;
constexpr float C2 = 1.4426950408889634f * 0.08838834764831845f;
constexpr float THR = 8.0f;
__device__ __forceinline__ unsigned cvtpk(float lo, float hi) { unsigned r; asm volatile("v_cvt_pk_bf16_f32 %0, %1, %2" : "=v"(r) : "v"(lo), "v"(hi)); return r; }
struct Block { const unsigned short* Q; const unsigned short* K; const unsigned short* V0; const unsigned short* V1; unsigned short* O; int qb; };
__device__ __forceinline__ void dma_offsets(int (&doff)[4], int wave, int lane) {
    const int rin = lane >> 4, chs = lane & 15;
#pragma unroll
    for (int i = 0; i < 2; ++i) { const int row = 4 * (i * 8 + wave) + rin; doff[2 + i] = 256 * row + 16 * (chs ^ (((row & 7) << 1) | ((row >> 3) & 1))); doff[i] = 256 * row + 16 * (chs ^ ((row + 4) & 15)); }
}
__device__ __forceinline__ void dma_tile(const unsigned short* pK, const unsigned short* pV0, const unsigned short* pV1, const int (&doff)[4], int t, int st, AX_LAS unsigned char* lds, int wave) {
#pragma unroll
    for (int i = 0; i < 6; ++i) {
        const unsigned short* base = i < 2 ? pK : (i < 4 ? pV0 : pV1);
        const char* src = (const char*)base + (size_t)t * 16384 + (unsigned)doff[(i < 2 ? 0 : 2) + (i & 1)];
        __builtin_amdgcn_global_load_lds((const unsigned*)src, (AX_LAS unsigned*)(lds + st * STAGE_BYTES + (i * 8 + wave) * 1024), 16, 0, 0);
    }
}
__device__ __forceinline__ void attn_block(const Block& B, AX_LAS unsigned char* lds, int wave, int lane) {
    const int qi = lane & 15, g = lane >> 4, q0 = B.qb * 256 + 32 * wave;
    const int NT = 4 * (B.qb + 1);
    const unsigned short* pK = B.K; const unsigned short* pV0 = B.V0; const unsigned short* pV1 = B.V1;
    int doff[4]; dma_offsets(doff, wave, lane);
    dma_tile(pK, pV0, pV1, doff, 0, 0, lds, wave);
    bf16x8 qf[2][4];
#pragma unroll
    for (int rb = 0; rb < 2; ++rb)
#pragma unroll
        for (int s = 0; s < 4; ++s) qf[rb][s] = *(const bf16x8*)(B.Q + (size_t)(q0 + 16 * rb + qi) * 128 + 32 * s + 8 * g);
    f32x4 o[2][16];
#pragma unroll
    for (int rb = 0; rb < 2; ++rb)
#pragma unroll
        for (int cb = 0; cb < 16; ++cb) o[rb][cb] = (f32x4){0.f, 0.f, 0.f, 0.f};
    float mref[2] = {-1e30f, -1e30f}, lsum[2] = {0.f, 0.f};
    const int mk = (qi + 4) & 15, mk2 = mk >> 2, kbase_l = 256 * qi + 16 * (g ^ (mk & 3));
    const int rv = 4 * g + (qi >> 2), mv = ((rv & 7) << 1) | (rv >> 3), mv3 = mv >> 1, vbase_l = 16384 + 256 * (4 * g + (qi >> 2)) + 16 * (((qi & 3) >> 1) ^ (mv & 1)) + 8 * (qi & 1);
    for (int t = 0; t < NT; ++t) {
        asm volatile("s_waitcnt vmcnt(0)" ::: "memory");
        __builtin_amdgcn_s_barrier();
        asm volatile("" ::: "memory");
        if (t + 1 < NT) dma_tile(pK, pV0, pV1, doff, t + 1, (t + 1) & 1, lds, wave);
        if (64 * t > q0 + 31) continue;
        const AX_LAS unsigned char* stg = lds + (t & 1) * STAGE_BYTES;
        f32x4 sc[2][4];
#pragma unroll
        for (int kb = 0; kb < 4; ++kb) {
            sc[0][kb] = (f32x4){0.f, 0.f, 0.f, 0.f}; sc[1][kb] = (f32x4){0.f, 0.f, 0.f, 0.f};
#pragma unroll
            for (int s = 0; s < 4; ++s) { const bf16x8 kf = *(const AX_LAS bf16x8*)(stg + 4096 * kb + kbase_l + 64 * (s ^ mk2));
                sc[0][kb] = __builtin_amdgcn_mfma_f32_16x16x32_bf16(kf, qf[0][s], sc[0][kb], 0, 0, 0);
                sc[1][kb] = __builtin_amdgcn_mfma_f32_16x16x32_bf16(kf, qf[1][s], sc[1][kb], 0, 0, 0); } }
        if (64 * t + 63 > q0) {
#pragma unroll
            for (int rb = 0; rb < 2; ++rb) { const int qpos = q0 + 16 * rb + qi;
#pragma unroll
                for (int kb = 0; kb < 4; ++kb)
#pragma unroll
                    for (int r = 0; r < 4; ++r) if (64 * t + 16 * kb + 4 * g + r > qpos) sc[rb][kb][r] = -__builtin_inff(); } }
        float pm[2];
#pragma unroll
        for (int rb = 0; rb < 2; ++rb) { float m = fmaxf(fmaxf(sc[rb][0][0], sc[rb][0][1]), fmaxf(sc[rb][0][2], sc[rb][0][3]));
#pragma unroll
            for (int kb = 1; kb < 4; ++kb) m = fmaxf(m, fmaxf(fmaxf(sc[rb][kb][0], sc[rb][kb][1]), fmaxf(sc[rb][kb][2], sc[rb][kb][3])));
            m = fmaxf(m, __shfl_xor(m, 16)); m = fmaxf(m, __shfl_xor(m, 32)); pm[rb] = m; }
        if (!__all((pm[0] - mref[0]) * C2 <= THR && (pm[1] - mref[1]) * C2 <= THR)) {
#pragma unroll
            for (int rb = 0; rb < 2; ++rb) { const float mn = fmaxf(mref[rb], pm[rb]), al = __builtin_amdgcn_exp2f((mref[rb] - mn) * C2); mref[rb] = mn; lsum[rb] *= al;
#pragma unroll
                for (int cb = 0; cb < 16; ++cb) o[rb][cb] = o[rb][cb] * al; } }
        u32x4 pf[2][2];
#pragma unroll
        for (int rb = 0; rb < 2; ++rb) { const float mb = -mref[rb] * C2; float ps = 0.f;
#pragma unroll
            for (int kb = 0; kb < 4; ++kb)
#pragma unroll
                for (int r = 0; r < 4; ++r) { const float p = __builtin_amdgcn_exp2f(fmaf(sc[rb][kb][r], C2, mb)); sc[rb][kb][r] = p; ps += p; }
            lsum[rb] += ps;
#pragma unroll
            for (int ks = 0; ks < 2; ++ks) pf[rb][ks] = (u32x4){cvtpk(sc[rb][2 * ks][0], sc[rb][2 * ks][1]), cvtpk(sc[rb][2 * ks][2], sc[rb][2 * ks][3]), cvtpk(sc[rb][2 * ks + 1][0], sc[rb][2 * ks + 1][1]), cvtpk(sc[rb][2 * ks + 1][2], sc[rb][2 * ks + 1][3])}; }
        const int sbase = (int)(unsigned)(unsigned long long)(stg);
#pragma unroll
        for (int ks = 0; ks < 2; ++ks)
#pragma unroll
            for (int hv = 0; hv < 2; ++hv) {
#pragma unroll
                for (int cq = 0; cq < 2; ++cq) {
                    s16x4 v0[4], v1[4];
#pragma unroll
                    for (int c = 0; c < 4; ++c) { const int a = sbase + vbase_l + 32 * ((4 * cq + c) ^ mv3);
                        asm volatile("ds_read_b64_tr_b16 %0, %1 offset:%2" : "=&v"(v0[c]) : "v"(a), "i"(16384 * hv + 4096 * (2 * ks)) : "memory");
                        asm volatile("ds_read_b64_tr_b16 %0, %1 offset:%2" : "=&v"(v1[c]) : "v"(a), "i"(16384 * hv + 4096 * (2 * ks + 1)) : "memory"); }
                    asm volatile("s_waitcnt lgkmcnt(0)" ::: "memory"); __builtin_amdgcn_sched_barrier(0);
#pragma unroll
                    for (int c = 0; c < 4; ++c) { const bf16x8 vf = (bf16x8){v0[c][0], v0[c][1], v0[c][2], v0[c][3], v1[c][0], v1[c][1], v1[c][2], v1[c][3]};
                        o[0][8 * hv + 4 * cq + c] = __builtin_amdgcn_mfma_f32_16x16x32_bf16(vf, __builtin_bit_cast(bf16x8, pf[0][ks]), o[0][8 * hv + 4 * cq + c], 0, 0, 0);
                        o[1][8 * hv + 4 * cq + c] = __builtin_amdgcn_mfma_f32_16x16x32_bf16(vf, __builtin_bit_cast(bf16x8, pf[1][ks]), o[1][8 * hv + 4 * cq + c], 0, 0, 0); }
                }
            }
    }
#pragma unroll
    for (int rb = 0; rb < 2; ++rb) { float l = lsum[rb]; l += __shfl_xor(l, 16); l += __shfl_xor(l, 32); const float il = 1.0f / l;
        unsigned short* orow = B.O + (size_t)(q0 + 16 * rb + qi) * 256 + 4 * g;
#pragma unroll
        for (int cb = 0; cb < 16; ++cb) { const f32x4 v = o[rb][cb] * il; *(u32x2*)(orow + 16 * cb) = (u32x2){cvtpk(v[0], v[1]), cvtpk(v[2], v[3])}; } }
}
}
#define GAS __attribute__((address_space(1)))
#define LAS __attribute__((address_space(3)))
typedef unsigned short bf16;
typedef unsigned v4u __attribute__((ext_vector_type(4)));
typedef float f32x4 __attribute__((ext_vector_type(4)));
typedef short bf16x8 __attribute__((ext_vector_type(8)));
typedef GAS unsigned gu32;
typedef GAS unsigned long long gu64;
#define RLX_AGENT __ATOMIC_RELAXED, __HIP_MEMORY_SCOPE_AGENT
#define LDS_WAIT() asm volatile("s_waitcnt lgkmcnt(0)" ::: "memory")
#define VM_WAIT() asm volatile("s_waitcnt vmcnt(0)" ::: "memory")
__device__ __forceinline__ unsigned long long rt() { return __builtin_amdgcn_s_memrealtime(); }
__device__ __forceinline__ unsigned f2bf(float f) { unsigned u = __builtin_bit_cast(unsigned, f); return (u + 0x7fffu + ((u >> 16) & 1u)) >> 16; }
__device__ __forceinline__ unsigned pk2(float lo, float hi) { return f2bf(lo) | (f2bf(hi) << 16); }

#define XB_TMO      128
#define XB_XCNT(j)  (256  + 64 * (j))
#define XB_XSUB(j)  (1280 + 64 * (j))
#define XB_XGEN(j)  (2304 + 64 * (j))
#define XB_TOP      3328
#define XB_TOPGEN   3392
#define XCD_BAR_WORDS 3456
#define XB_SPIN_CAP (1u << 18)

__device__ __forceinline__ unsigned xb_ld(unsigned* p)              { return __hip_atomic_load(p, __ATOMIC_RELAXED, __HIP_MEMORY_SCOPE_AGENT); }
__device__ __forceinline__ unsigned xb_add(unsigned* p, unsigned v) { return __hip_atomic_fetch_add(p, v, __ATOMIC_RELAXED, __HIP_MEMORY_SCOPE_AGENT); }
__device__ __forceinline__ unsigned xb_xcc_id() { return (unsigned)__builtin_amdgcn_s_getreg((3 << 11) | 20) & 0xFu; }
#define XB_SPIN(cond, bar) do { unsigned _sp = 0; while (cond) { __builtin_amdgcn_s_sleep(1); \
    if ((++_sp & 255u) == 0u) { if (xb_ld(&(bar)[XB_TMO])) break; if (_sp > XB_SPIN_CAP) { atomicAdd(&(bar)[XB_TMO], 1u); break; } } } } while (0)

struct XcdBarrier {
    unsigned* bar; unsigned x;
    volatile LAS unsigned* st;
};

__device__ __forceinline__ XcdBarrier xcd_barrier_post(unsigned* bar, volatile LAS unsigned* st) {
    XcdBarrier b; b.bar = bar; b.x = xb_xcc_id(); b.st = st;
    if (threadIdx.x == 0) (void)xb_add(&bar[XB_XCNT(b.x)], 1u);
    return b;
}
__device__ __forceinline__ void xcd_barrier_complete(unsigned* bar, unsigned x, unsigned& nloc, unsigned& nx) {
    const unsigned G = gridDim.x * gridDim.y * gridDim.z;
    unsigned sum, cnt, mine, sp = 0u;
    for (;;) {
        sum = 0u; cnt = 0u; mine = 0u;
#pragma unroll
        for (unsigned j = 0; j < 16; ++j) { const unsigned c = xb_ld(&bar[XB_XCNT(j)]); sum += c; cnt += (c > 0u) ? 1u : 0u; mine = (j == x) ? c : mine; }
        if (sum == G) break;
        __builtin_amdgcn_s_sleep(1);
        if ((++sp & 255u) == 0u) { if (xb_ld(&bar[XB_TMO])) break; if (sp > XB_SPIN_CAP) { atomicAdd(&bar[XB_TMO], 1u); break; } }
    }
    nloc = mine > 0u ? mine : 1u; nx = cnt > 0u ? cnt : 1u;
}

__device__ __forceinline__ void xcd_barrier(const XcdBarrier& b, const int tid_in) {
    asm volatile("s_waitcnt vmcnt(0)" ::: "memory");
    __syncthreads();
    if (tid_in == 0) {
        unsigned* bar = b.bar;
        __builtin_amdgcn_s_waitcnt(0);
        unsigned nloc = b.st[0], nx = b.st[1];
        if (nloc == 0u) { xcd_barrier_complete(bar, b.x, nloc, nx); b.st[0] = nloc; b.st[1] = nx; }
        const unsigned old = xb_add(&bar[XB_XSUB(b.x)], 1u);
        const unsigned gen = old / nloc;
        if (old + 1u == (gen + 1u) * nloc) {
            __builtin_amdgcn_fence(__ATOMIC_RELEASE, "agent");
            asm volatile("s_waitcnt vmcnt(0)" ::: "memory");
            const unsigned og = xb_add(&bar[XB_TOP], 1u);
            const unsigned tg = og / nx;
            if (og + 1u == (tg + 1u) * nx) xb_add(&bar[XB_TOPGEN], 1u);
            else XB_SPIN(xb_ld(&bar[XB_TOPGEN]) == tg, bar);
            __builtin_amdgcn_fence(__ATOMIC_ACQUIRE, "agent");
            xb_add(&bar[XB_XGEN(b.x)], 1u);
            asm volatile("s_waitcnt vmcnt(0)" ::: "memory");
        } else {
            XB_SPIN(xb_ld(&bar[XB_XGEN(b.x)]) == gen, bar);
            __builtin_amdgcn_fence(__ATOMIC_ACQUIRE, "agent");
            asm volatile("s_waitcnt vmcnt(0)" ::: "memory");
        }
    }
    __syncthreads();
}

constexpr int NWAVES = 8;
#ifndef MK_N_LAUNCHES
#define MK_N_LAUNCHES 1
#endif
constexpr int N_PHASES = 13;
#ifndef CV_SPLIT
#define CV_SPLIT 1
#endif
constexpr int N_LAUNCHES = MK_N_LAUNCHES;
static_assert(N_LAUNCHES == 1 || N_LAUNCHES == N_PHASES, "MK_N_LAUNCHES is 1 or 13");
constexpr int NB = 4, SEQ = 2048, DM = 4096, M = NB * SEQ, DFF = 11008, DPOOL = 1024, NH = 12, DIN = 10240, NMOD = 9 * DM;
constexpr float EPS = 1e-6f;
#ifndef FFN2_DOWN_FP8
#define FFN2_DOWN_FP8 0
#endif
#ifndef FFN_UP_INT8
#define FFN_UP_INT8 1
#endif
#ifndef DOWN_AUXA
#define DOWN_AUXA 0
#endif
#ifndef DOWN_AUXB
#define DOWN_AUXB 0
#endif
#ifndef ATTN_V2
#define ATTN_V2 1
#endif
#ifndef W2_IDLE_PCT
#define W2_IDLE_PCT 55
#endif
constexpr float F8_SA = 4.0f, F8_SW = 2048.0f;
constexpr float ONE_MINUS_LAMBDA_INIT = 0.8f, LAMBDA_INIT = 0.2f;

constexpr size_t MiB = 1u << 20;
constexpr size_t WS_CTL = 0, CTL_ZERO_BYTES = 1 * MiB;
constexpr size_t WS_MOD = 1 * MiB;
constexpr size_t WS_WPT = 2 * MiB;
constexpr size_t WS_W13A = 4 * MiB, WS_W2A = 176 * MiB, WS_W13B = 262 * MiB, WS_W2B = 434 * MiB, WS_WIN = 520 * MiB, WS_WOUT = 600 * MiB;
constexpr size_t WS_XN = 632 * MiB;
constexpr size_t WS_ACT = 696 * MiB;
constexpr size_t WS_F = 868 * MiB;
constexpr size_t WS_U = 996 * MiB;
constexpr size_t WS_QKV = 1012 * MiB;
constexpr size_t WS_O4 = 1156 * MiB;
constexpr size_t WS_MIX = 1252 * MiB;
constexpr size_t WS_XR = 1316 * MiB;
constexpr size_t WS_END = 1380 * MiB;
static_assert(WS_W13A + (size_t)2 * DFF * DM * 2 <= WS_W2A && WS_W2A + (size_t)DFF * DM * 2 <= WS_W13B && WS_W13B + (size_t)2 * DFF * DM * 2 <= WS_W2B && WS_W2B + (size_t)DFF * DM * 2 <= WS_WIN, "ws map 1");
static_assert(WS_WIN + (size_t)DIN * DM * 2 <= WS_WOUT && WS_WOUT + (size_t)DM * DM * 2 <= WS_XN && WS_XN + (size_t)M * DM * 2 <= WS_ACT && WS_ACT + (size_t)M * DFF * 2 <= WS_F && WS_F + (size_t)M * DM * 4 <= WS_U, "ws map 2");
static_assert(WS_U + (size_t)M * DPOOL * 2 <= WS_QKV && WS_QKV + (size_t)3 * M * 3072 * 2 <= WS_O4 && WS_O4 + (size_t)M * 6144 * 2 <= WS_MIX && WS_MIX + (size_t)M * DM * 2 <= WS_END, "ws map 3");
constexpr int CW_BAR = 4096;
constexpr int CW_AMAX = 32768;
constexpr size_t WS_RS = 1 * MiB + 768 * 1024;
static_assert((CW_AMAX + 4 * DFF) * 4 <= (int)CTL_ZERO_BYTES && (size_t)NB * NMOD * 4 <= 768 * 1024, "ctl / mod map");

constexpr int RING_OFF = 0, RING_BYTES = 131072;
constexpr int LDSCTL_OFF = RING_BYTES, MISC_OFF = LDSCTL_OFF + 320;
constexpr int LDS_BYTES = 147456;
static_assert(MISC_OFF + 128 <= LDS_BYTES, "LDS map");

__device__ __forceinline__ float wave_sum(float v) {
#pragma unroll
    for (int o = 1; o < 64; o <<= 1) v += __shfl_xor(v, o);
    return v;
}
__device__ __forceinline__ float wave_max(float v) {
#pragma unroll
    for (int o = 1; o < 64; o <<= 1) v = fmaxf(v, __shfl_xor(v, o));
    return v;
}
__device__ __forceinline__ float bf_lo(unsigned w) { return __uint_as_float(w << 16); }
__device__ __forceinline__ float bf_hi(unsigned w) { return __uint_as_float(w & 0xffff0000u); }

__device__ __forceinline__ __amdgpu_buffer_rsrc_t mkrsrc(const void* p, unsigned bytes) {
    const unsigned long long a = (unsigned long long)p;
    const unsigned lo = __builtin_amdgcn_readfirstlane((unsigned)a), hi = __builtin_amdgcn_readfirstlane((unsigned)(a >> 32));
    return __builtin_amdgcn_make_buffer_rsrc((void*)(((unsigned long long)hi << 32) | lo), 0, bytes, 0x00020000);
}
__device__ __forceinline__ void p0_adaln(const float* c, const float* w_ada, const float* b_ada, float* mod, LAS unsigned char* lds, int wg, int G, int tid) {
    LAS float* sil = (LAS float*)lds;
    LAS float* red = (LAS float*)(lds + 65536);
    for (int i = tid; i < NB * DM; i += NWAVES * 64) { const int b = i / DM, k = i % DM; const float v = c[i]; sil[k * 4 + b] = v / (1.f + __expf(-v)); }
    __syncthreads();
    const int wave = tid >> 6, lane = tid & 63;
    for (int ch = wg; ch < 256; ch += G) {
        const int j0 = ch * 144;
        if (lane < 36) {
            f32x4 a0 = {0.f, 0.f, 0.f, 0.f}, a1 = a0, a2 = a0, a3 = a0;
            const float* wp = w_ada + (size_t)(wave * 512) * NMOD + j0 + 4 * lane;
            const LAS float* sp = sil + wave * 512 * 4;
            for (int k = 0; k < 512; k += 16) {
                f32x4 w[16];
#pragma unroll
                for (int u = 0; u < 16; ++u) w[u] = __builtin_nontemporal_load((const GAS f32x4*)(wp + (size_t)(k + u) * NMOD));
#pragma unroll
                for (int u = 0; u < 16; ++u) { const f32x4 s = *(const LAS f32x4*)(sp + (k + u) * 4); a0 += w[u] * s.x; a1 += w[u] * s.y; a2 += w[u] * s.z; a3 += w[u] * s.w; }
            }
            LAS float* r = red + wave * 576 + 4 * lane;
            *(LAS f32x4*)(r) = a0; *(LAS f32x4*)(r + 144) = a1; *(LAS f32x4*)(r + 288) = a2; *(LAS f32x4*)(r + 432) = a3;
        }
        __syncthreads();
        for (int o = tid; o < 576; o += NWAVES * 64) { const int b = o / 144, col = o % 144; float s = 0.f;
#pragma unroll
            for (int w = 0; w < 8; ++w) s += red[w * 576 + o];
            mod[b * NMOD + j0 + col] = s + b_ada[j0 + col]; }
        __syncthreads();
    }
}
typedef unsigned v2u __attribute__((ext_vector_type(2)));
constexpr int CV_TP = 68, CV_TILE_BYTES = 64 * CV_TP * 2;
struct CvMat { const float* W; bf16* WT; int K, N, mode; };
__device__ __forceinline__ void cv_load(const CvMat& m, int item, int lane, f32x4 (&v)[16]) {
    const int nblk = m.N / 64, kb = item / nblk, nb = item % nblk;
    const float* src = m.W + (size_t)(64 * kb + (lane >> 4)) * m.N + 64 * nb + 4 * (lane & 15);
#pragma unroll
    for (int i = 0; i < 16; ++i) v[i] = __builtin_nontemporal_load((const GAS f32x4*)(src + (size_t)(4 * i) * m.N));
}
__device__ __forceinline__ void cv_matrix(const CvMat& m, LAS unsigned short* T, int first, int stride, int lane, int it_lo = 0, int it_hi = 0x7fffffff) {
    const int nblk = m.N / 64, ntot = (m.K / 64) * nblk, nitems = it_hi < ntot ? it_hi : ntot;
    first += it_lo;
    if (first >= nitems) return;
    f32x4 v[16];
    cv_load(m, first, lane, v);
    for (int it = first; it < nitems; it += stride) {
        { const int kq = lane >> 4, nq = 4 * (lane & 15);
#pragma unroll
          for (int i = 0; i < 16; ++i) { v2u w; w.x = pk2(v[i].x, v[i].y); w.y = pk2(v[i].z, v[i].w); *(LAS v2u*)(T + (4 * i + kq) * CV_TP + nq) = w; } }
        LDS_WAIT(); asm volatile("" ::: "memory");
        if (it + stride < nitems) cv_load(m, it + stride, lane, v);
        const int kb = it / nblk, nb = it % nblk, k0 = 64 * kb, n0 = 64 * nb;
        const int orow0 = m.mode == 0 ? n0 : (256 * (n0 >> 7) + (n0 & 127) + 128 * (m.mode - 1));
        const int c = lane & 7, nl = lane >> 3;
#pragma unroll
        for (int p = 0; p < 8; ++p) { const int n = 8 * p + nl; const LAS unsigned short* s = T + (8 * c) * CV_TP + n;
            v4u o; o.x = (unsigned)s[0] | ((unsigned)s[CV_TP] << 16); o.y = (unsigned)s[2 * CV_TP] | ((unsigned)s[3 * CV_TP] << 16);
            o.z = (unsigned)s[4 * CV_TP] | ((unsigned)s[5 * CV_TP] << 16); o.w = (unsigned)s[6 * CV_TP] | ((unsigned)s[7 * CV_TP] << 16);
            *(GAS v4u*)(m.WT + (size_t)(orow0 + n) * m.K + k0 + 8 * c) = o; }
        LDS_WAIT(); asm volatile("" ::: "memory");
    }
}
__device__ __forceinline__ void cv8_matrix(const float* W, int K, int N, unsigned char* WT, float scale, LAS unsigned char* T, int first, int stride, int lane) {
    const int nblk = N / 64, nitems = (K / 64) * nblk;
    if (first >= nitems) return;
    CvMat m; m.W = W; m.WT = nullptr; m.K = K; m.N = N; m.mode = 0;
    f32x4 v[16];
    cv_load(m, first, lane, v);
    for (int it = first; it < nitems; it += stride) {
        { const int kq = lane >> 4, nq = 4 * (lane & 15);
#pragma unroll
          for (int i = 0; i < 16; ++i) { const f32x4 s = v[i] * scale;
              int w = __builtin_amdgcn_cvt_pk_fp8_f32(__builtin_amdgcn_fmed3f(s.x, -448.f, 448.f), __builtin_amdgcn_fmed3f(s.y, -448.f, 448.f), 0, false);
              w = __builtin_amdgcn_cvt_pk_fp8_f32(__builtin_amdgcn_fmed3f(s.z, -448.f, 448.f), __builtin_amdgcn_fmed3f(s.w, -448.f, 448.f), w, true);
              *(LAS int*)(T + (4 * i + kq) * 68 + nq) = w; } }
        LDS_WAIT(); asm volatile("" ::: "memory");
        if (it + stride < nitems) cv_load(m, it + stride, lane, v);
        const int kb = it / nblk, nb = it % nblk, k0 = 64 * kb, n0 = 64 * nb;
        const int c = lane & 3, nl = lane >> 2;
#pragma unroll
        for (int p = 0; p < 4; ++p) { const int n = 16 * p + nl; const LAS unsigned char* s = T + (16 * c) * 68 + n;
            v4u o;
            o.x = (unsigned)s[0 * 68] | ((unsigned)s[1 * 68] << 8) | ((unsigned)s[2 * 68] << 16) | ((unsigned)s[3 * 68] << 24);
            o.y = (unsigned)s[4 * 68] | ((unsigned)s[5 * 68] << 8) | ((unsigned)s[6 * 68] << 16) | ((unsigned)s[7 * 68] << 24);
            o.z = (unsigned)s[8 * 68] | ((unsigned)s[9 * 68] << 8) | ((unsigned)s[10 * 68] << 16) | ((unsigned)s[11 * 68] << 24);
            o.w = (unsigned)s[12 * 68] | ((unsigned)s[13 * 68] << 8) | ((unsigned)s[14 * 68] << 16) | ((unsigned)s[15 * 68] << 24);
            *(GAS v4u*)(WT + (size_t)(n0 + n) * K + k0 + 16 * c) = o; }
        LDS_WAIT(); asm volatile("" ::: "memory");
    }
}
__device__ __forceinline__ void amax_pass(const float* W, int K, int N, gu32* amax, int first, int stride, int lane) {
    const int ncg = N / 256, nitems = (K / 256) * ncg;
    for (int it = first; it < nitems; it += stride) {
        const int kb = it / ncg, cg = it % ncg;
        const float* src = W + (size_t)(256 * kb) * N + 256 * cg + 4 * lane;
        f32x4 mx = {0.f, 0.f, 0.f, 0.f};
#pragma unroll 1
        for (int k = 0; k < 256; k += 16) {
            f32x4 v[16];
#pragma unroll
            for (int u = 0; u < 16; ++u) v[u] = *(const GAS f32x4*)(src + (size_t)(k + u) * N);
#pragma unroll
            for (int u = 0; u < 16; ++u) { mx.x = fmaxf(mx.x, fabsf(v[u].x)); mx.y = fmaxf(mx.y, fabsf(v[u].y)); mx.z = fmaxf(mx.z, fabsf(v[u].z)); mx.w = fmaxf(mx.w, fabsf(v[u].w)); }
        }
        gu32* d = amax + 256 * cg + 4 * lane;
        __hip_atomic_fetch_max(d + 0, __float_as_uint(mx.x), RLX_AGENT); __hip_atomic_fetch_max(d + 1, __float_as_uint(mx.y), RLX_AGENT);
        __hip_atomic_fetch_max(d + 2, __float_as_uint(mx.z), RLX_AGENT); __hip_atomic_fetch_max(d + 3, __float_as_uint(mx.w), RLX_AGENT);
    }
}
__device__ __forceinline__ unsigned q8pack(f32x4 s) {
    const int a = (int)__builtin_rintf(s.x), b = (int)__builtin_rintf(s.y), c = (int)__builtin_rintf(s.z), d = (int)__builtin_rintf(s.w);
    return ((unsigned)a & 255u) | (((unsigned)b & 255u) << 8) | (((unsigned)c & 255u) << 16) | ((unsigned)d << 24);
}
__device__ __forceinline__ void cvi8_matrix(const float* W, int K, int N, int mode, unsigned char* WT, const gu32* amax, LAS unsigned char* T, int first, int stride, int lane) {
    const int nblk = N / 64, nitems = (K / 64) * nblk;
    if (first >= nitems) return;
    CvMat m; m.W = W; m.WT = nullptr; m.K = K; m.N = N; m.mode = mode;
    f32x4 v[16];
    cv_load(m, first, lane, v);
    for (int it = first; it < nitems; it += stride) {
        const int kb = it / nblk, nb = it % nblk, k0 = 64 * kb, n0 = 64 * nb;
        { const int kq = lane >> 4, nq = 4 * (lane & 15);
          const v4u am = *(const GAS v4u*)(amax + n0 + nq);
          f32x4 inv; inv.x = 127.0f / fmaxf(__uint_as_float(am.x), 1e-30f); inv.y = 127.0f / fmaxf(__uint_as_float(am.y), 1e-30f); inv.z = 127.0f / fmaxf(__uint_as_float(am.z), 1e-30f); inv.w = 127.0f / fmaxf(__uint_as_float(am.w), 1e-30f);
#pragma unroll
          for (int i = 0; i < 16; ++i) *(LAS unsigned*)(T + (4 * i + kq) * 68 + nq) = q8pack(v[i] * inv); }
        LDS_WAIT(); asm volatile("" ::: "memory");
        if (it + stride < nitems) cv_load(m, it + stride, lane, v);
        const int orow0 = mode == 0 ? n0 : (256 * (n0 >> 7) + (n0 & 127) + 128 * (mode - 1));
        const int c = lane & 3, nl = lane >> 2;
#pragma unroll
        for (int p = 0; p < 4; ++p) { const int n = 16 * p + nl; const LAS unsigned char* s = T + (16 * c) * 68 + n;
            v4u o;
            o.x = (unsigned)s[0 * 68] | ((unsigned)s[1 * 68] << 8) | ((unsigned)s[2 * 68] << 16) | ((unsigned)s[3 * 68] << 24);
            o.y = (unsigned)s[4 * 68] | ((unsigned)s[5 * 68] << 8) | ((unsigned)s[6 * 68] << 16) | ((unsigned)s[7 * 68] << 24);
            o.z = (unsigned)s[8 * 68] | ((unsigned)s[9 * 68] << 8) | ((unsigned)s[10 * 68] << 16) | ((unsigned)s[11 * 68] << 24);
            o.w = (unsigned)s[12 * 68] | ((unsigned)s[13 * 68] << 8) | ((unsigned)s[14 * 68] << 16) | ((unsigned)s[15 * 68] << 24);
            *(GAS v4u*)(WT + (size_t)(orow0 + n) * K + k0 + 16 * c) = o; }
        LDS_WAIT(); asm volatile("" ::: "memory");
    }
}
__device__ __forceinline__ void w13_convert8(const float* w1, const float* w3, unsigned char* WT, const gu32* amax1, const gu32* amax3, LAS unsigned char* lds, int gw, int NGW, int wave, int lane) {
    LAS unsigned char* T = lds + wave * CV_TILE_BYTES;
    constexpr int NIT = (DM / 64) * (DFF / 64);
    cvi8_matrix(w1, DM, DFF, 1, WT, amax1, T, gw, NGW, lane);
    int first = (gw - NIT) % NGW; if (first < 0) first += NGW;
    cvi8_matrix(w3, DM, DFF, 2, WT, amax3, T, first, NGW, lane);
}
__device__ __forceinline__ void strip_convert_i8(const float* W, int mode, unsigned char* WT, float* amaxOut, LAS float* red  , int strip, int wave, int lane) {
    const int n0 = strip * 32, c = lane & 31, kh = lane >> 5, n = n0 + c;
    const __amdgpu_buffer_rsrc_t rw = mkrsrc(W + (size_t)(wave * 512) * DFF, 512u * DFF * 4u);
    int voff = (kh * 256 * DFF + n) * 4; asm volatile("" : "+v"(voff));
    unsigned pk[128]; float mx = 0.f;
#pragma unroll
    for (int blk = 0; blk < 8; ++blk) {
        float t[32];
#pragma unroll
        for (int u = 0; u < 32; ++u) t[u] = __uint_as_float(__builtin_amdgcn_raw_buffer_load_b32(rw, voff + (32 * blk + u) * DFF * 4, 0, 2));
#pragma unroll
        for (int u = 0; u < 16; ++u) { mx = fmaxf(mx, fmaxf(fabsf(t[2 * u]), fabsf(t[2 * u + 1]))); pk[16 * blk + u] = pk2(t[2 * u], t[2 * u + 1]); }
        asm volatile("" : "+v"(pk[16 * blk]), "+v"(pk[16 * blk + 1]), "+v"(pk[16 * blk + 2]), "+v"(pk[16 * blk + 3]), "+v"(pk[16 * blk + 4]), "+v"(pk[16 * blk + 5]), "+v"(pk[16 * blk + 6]), "+v"(pk[16 * blk + 7]),
                         "+v"(pk[16 * blk + 8]), "+v"(pk[16 * blk + 9]), "+v"(pk[16 * blk + 10]), "+v"(pk[16 * blk + 11]), "+v"(pk[16 * blk + 12]), "+v"(pk[16 * blk + 13]), "+v"(pk[16 * blk + 14]), "+v"(pk[16 * blk + 15]) :: "memory");
    }
    mx = fmaxf(mx, __shfl_xor(mx, 32));
    if (kh == 0) red[wave * 32 + c] = mx;
    __syncthreads();
    float am = red[c];
#pragma unroll
    for (int w = 1; w < 8; ++w) am = fmaxf(am, red[w * 32 + c]);
    if (wave == 0 && kh == 0) amaxOut[n] = am;
    const float inv = 127.0f / fmaxf(am, 1e-30f);
    const int orow = mode == 0 ? n : (256 * (n >> 7) + (n & 127) + 128 * (mode - 1));
    const __amdgpu_buffer_rsrc_t ro = mkrsrc(WT, 0xffffffffu);
    const int vo = orow * DM + wave * 512 + kh * 256;
#pragma unroll
    for (int j = 0; j < 16; ++j) {
        v4u o;
#pragma unroll
        for (int q = 0; q < 4; ++q) { const unsigned p0 = pk[8 * j + 2 * q], p1 = pk[8 * j + 2 * q + 1];
            const f32x4 s = (f32x4){bf_lo(p0), bf_hi(p0), bf_lo(p1), bf_hi(p1)} * inv; o[q] = q8pack(s); }
        __builtin_amdgcn_raw_buffer_store_b128(o, ro, vo, 16 * j, 0); }
    __syncthreads();
}
__device__ __forceinline__ void w13_strips_i8(const float* w1, const float* w3, unsigned char* WT, float* amax1, float* amax3, LAS unsigned char* lds, int vcu, int G, int wave, int lane) {
    constexpr int NS = DFF / 32;
    for (int s = vcu; s < 2 * NS; s += G) {
        if (s < NS) strip_convert_i8(w1, 1, WT, amax1, (LAS float*)lds, s, wave, lane);
        else strip_convert_i8(w3, 2, WT, amax3, (LAS float*)lds, s - NS, wave, lane);
    }
}
struct WPtrs { const float *f1w1, *f1w3, *f1w2, *f2w1, *f2w3, *f2w2, *win, *wout, *wpool; bf16 *W13A, *W2A, *W13B, *W2B, *WIN, *WOUT, *WPT; };
__device__ __forceinline__ void p0_convert(const WPtrs& P, LAS unsigned char* lds, int gw, int NGW, int wave, int lane, int m_lo, int m_hi) {
    LAS unsigned short* T = (LAS unsigned short*)(lds + wave * CV_TILE_BYTES);
    int cum = 0;
#pragma unroll 1
    for (int mi = m_lo; mi < m_hi; ++mi) {
        CvMat m;
        if (mi == 0)      { m.W = P.f1w1; m.WT = P.W13A; m.K = DM; m.N = DFF; m.mode = 1; }
        else if (mi == 1) { m.W = P.f1w3; m.WT = P.W13A; m.K = DM; m.N = DFF; m.mode = 2; }
        else if (mi < 6)  { m.W = P.wpool + (size_t)(mi - 2) * 65536; m.WT = P.WPT + (size_t)(mi - 2) * 65536; m.K = 256; m.N = 256; m.mode = 0; }
        else if (mi == 6) { m.W = P.win;  m.WT = P.WIN;  m.K = DM; m.N = DIN; m.mode = 0; }
        else if (mi == 7) { m.W = P.wout; m.WT = P.WOUT; m.K = DM; m.N = DM;  m.mode = 0; }
        else if (mi == 8) { m.W = P.f2w1; m.WT = P.W13B; m.K = DM; m.N = DFF; m.mode = 1; }
        else              { m.W = P.f2w3; m.WT = P.W13B; m.K = DM; m.N = DFF; m.mode = 2; }
        const int nitems = (m.K / 64) * (m.N / 64);
        int first = (gw - cum) % NGW; if (first < 0) first += NGW;
        cv_matrix(m, T, first, NGW, lane);
        cum += nitems;
    }
}
constexpr int W2_ITEMS = (DFF / 64) * (DM / 64), W2_SPLIT = (W2_ITEMS * W2_IDLE_PCT) / 100;
__device__ __forceinline__ void w2_convert(const float* W, bf16* WT, LAS unsigned char* lds, int rank, int nconv, int wave, int lane, int it_lo, int it_hi) {
    LAS unsigned short* T = (LAS unsigned short*)(lds + wave * CV_TILE_BYTES);
    CvMat m; m.W = W; m.WT = WT; m.K = DFF; m.N = DM; m.mode = 0;
    cv_matrix(m, T, rank * NWAVES + wave, nconv * NWAVES, lane, it_lo, it_hi);
}

__device__ __forceinline__ void w2_convert8(const float* W, unsigned char* WT, float scale, LAS unsigned char* lds, int rank, int nconv, int wave, int lane) {
    cv8_matrix(W, DFF, DM, WT, scale, lds + wave * CV_TILE_BYTES, rank * NWAVES + wave, nconv * NWAVES, lane);
}

__device__ __forceinline__ float sumsq4(f32x4 v) { return (v.x * v.x + v.y * v.y) + (v.z * v.z + v.w * v.w); }
#define RP_LD4(rs, j) __builtin_bit_cast(f32x4, __builtin_amdgcn_raw_buffer_load_b128((rs), lo16, 1024 * (j), 0))
#define RP_LD4NT(rs, j) __builtin_bit_cast(f32x4, __builtin_amdgcn_raw_buffer_load_b128((rs), lo16, 1024 * (j), 2))
#define RP_ST4NT(rs, j, val) __builtin_amdgcn_raw_buffer_store_b128(__builtin_bit_cast(v4u, (val)), (rs), lo16, 1024 * (j), 2)
#define RP_ST4(rs, j, val) __builtin_amdgcn_raw_buffer_store_b128(__builtin_bit_cast(v4u, (val)), (rs), lo16, 1024 * (j), 0)
#define RP_ST8(rs, j, a, b) __builtin_amdgcn_raw_buffer_store_b64((v2u){(a), (b)}, (rs), lo8, 512 * (j), 0)
__device__ __forceinline__ f32x4 bf4_to_f32(v2u w) { return (f32x4){bf_lo(w.x), bf_hi(w.x), bf_lo(w.y), bf_hi(w.y)}; }
#define RP_LDB4(rs, j) bf4_to_f32(__builtin_amdgcn_raw_buffer_load_b64((rs), lo8, 512 * (j), 0))
#define RP_LDB4NT(rs, j) bf4_to_f32(__builtin_amdgcn_raw_buffer_load_b64((rs), lo8, 512 * (j), 2))
#define RP_ST4B(rs_, j, val) __builtin_amdgcn_raw_buffer_store_b32((val), (rs_), lo4, 256 * (j), 0)
__device__ __forceinline__ float amax4(f32x4 v) { return fmaxf(fmaxf(fabsf(v.x), fabsf(v.y)), fmaxf(fabsf(v.z), fabsf(v.w))); }
template <bool Q8>
__device__ __forceinline__ void rowpass_first(const float* x, const float* g, const float* mod_sub  , bf16* XN, float* rs, int gw, int NGW, int lane) {
    const int lo16 = lane * 16, lo8 = lane * 8, lo4 = lane * 4;
    const __amdgpu_buffer_rsrc_t rg = mkrsrc(g, DM * 4);
    for (int m = gw; m < M; m += NGW) {
        const int b = m / SEQ;
        const __amdgpu_buffer_rsrc_t rx = mkrsrc(x + (size_t)m * DM, DM * 4), rsh = mkrsrc(mod_sub + (size_t)b * NMOD, DM * 4), rsc = mkrsrc(mod_sub + (size_t)b * NMOD + DM, DM * 4);
        f32x4 v[16]; float ss = 0.f;
#pragma unroll
        for (int j = 0; j < 16; ++j) { v[j] = RP_LD4NT(rx, j); ss += sumsq4(v[j]); }
        const float rstd = 1.f / sqrtf(wave_sum(ss) * (1.f / DM) + EPS);
        if constexpr (Q8) {
            const __amdgpu_buffer_rsrc_t ro = mkrsrc((unsigned char*)XN + (size_t)m * DM, DM);
            float mx = 0.f;
#pragma unroll
            for (int j = 0; j < 16; ++j) { const f32x4 gg = RP_LD4(rg, j), sh = RP_LD4(rsh, j), sc = RP_LD4(rsc, j); v[j] = (v[j] * rstd * gg) * (sc + 1.0f) + sh; mx = fmaxf(mx, amax4(v[j])); }
            const float am = fmaxf(wave_max(mx), 1e-20f), inv = 127.0f / am;
#pragma unroll
            for (int j = 0; j < 16; ++j) RP_ST4B(ro, j, q8pack(v[j] * inv));
            if (lane == 0) rs[m] = am * (1.0f / 127.0f);
        } else {
            const __amdgpu_buffer_rsrc_t ro = mkrsrc(XN + (size_t)m * DM, DM * 2);
#pragma unroll
            for (int j = 0; j < 16; ++j) { const f32x4 gg = RP_LD4(rg, j), sh = RP_LD4(rsh, j), sc = RP_LD4(rsc, j);
                const f32x4 h = (v[j] * rstd * gg) * (sc + 1.0f) + sh;
                RP_ST8(ro, j, pk2(h.x, h.y), pk2(h.z, h.w)); }
        }
    }
}
template <bool Q8, bool XIB, bool XOB>
__device__ __forceinline__ void rowpass_mid(const bf16* F, const void* xi, void* xo, bf16* XN, float* rs, const float* gpost, const float* gpre, const float* mod_cur  ,
                                            const float* mod_nxt  , float gmul, int gw, int NGW, int lane) {
    const int lo16 = lane * 16, lo8 = lane * 8, lo4 = lane * 4;
    const __amdgpu_buffer_rsrc_t rgpo = mkrsrc(gpost, DM * 4), rgpr = mkrsrc(gpre, DM * 4);
    for (int m = gw; m < M; m += NGW) {
        const int b = m / SEQ;
        const __amdgpu_buffer_rsrc_t rf_ = mkrsrc(F + (size_t)m * DM, DM * 2), rx = mkrsrc((const char*)xi + (size_t)m * DM * (XIB ? 2 : 4), DM * (XIB ? 2 : 4)), rw = mkrsrc((char*)xo + (size_t)m * DM * (XOB ? 2 : 4), DM * (XOB ? 2 : 4));
        const __amdgpu_buffer_rsrc_t rga = mkrsrc(mod_cur + (size_t)b * NMOD + 2 * DM, DM * 4), rsh = mkrsrc(mod_nxt + (size_t)b * NMOD, DM * 4), rsc = mkrsrc(mod_nxt + (size_t)b * NMOD + DM, DM * 4);
        f32x4 f[16], v[16]; float ss = 0.f;
#pragma unroll
        for (int j = 0; j < 16; ++j) { f[j] = RP_LDB4NT(rf_, j); ss += sumsq4(f[j]); }
#pragma unroll
        for (int j = 0; j < 16; ++j) { if constexpr (XIB) v[j] = RP_LDB4NT(rx, j); else v[j] = RP_LD4NT(rx, j); }
        const float rf = gmul / sqrtf(wave_sum(ss) * (1.f / DM) + EPS);
        float s2 = 0.f;
#pragma unroll
        for (int j = 0; j < 16; ++j) { const f32x4 gg = RP_LD4(rgpo, j), ga = RP_LD4(rga, j); v[j] = v[j] + ga * (f[j] * rf * gg);
            if constexpr (XOB) __builtin_amdgcn_raw_buffer_store_b64((v2u){pk2(v[j].x, v[j].y), pk2(v[j].z, v[j].w)}, rw, lo8, 512 * j, 2); else RP_ST4(rw, j, v[j]);
            s2 += sumsq4(v[j]); }
        const float rstd = 1.f / sqrtf(wave_sum(s2) * (1.f / DM) + EPS);
        if constexpr (Q8) {
            const __amdgpu_buffer_rsrc_t ro = mkrsrc((unsigned char*)XN + (size_t)m * DM, DM);
            float mx = 0.f;
#pragma unroll
            for (int j = 0; j < 16; ++j) { const f32x4 gg = RP_LD4(rgpr, j), sh = RP_LD4(rsh, j), sc = RP_LD4(rsc, j); v[j] = (v[j] * rstd * gg) * (sc + 1.0f) + sh; mx = fmaxf(mx, amax4(v[j])); }
            const float am = fmaxf(wave_max(mx), 1e-20f), inv = 127.0f / am;
#pragma unroll
            for (int j = 0; j < 16; ++j) RP_ST4B(ro, j, q8pack(v[j] * inv));
            if (lane == 0) rs[m] = am * (1.0f / 127.0f);
        } else {
            const __amdgpu_buffer_rsrc_t ro = mkrsrc(XN + (size_t)m * DM, DM * 2);
#pragma unroll
            for (int j = 0; j < 16; ++j) { const f32x4 gg = RP_LD4(rgpr, j), sh = RP_LD4(rsh, j), sc = RP_LD4(rsc, j);
                const f32x4 h = (v[j] * rstd * gg) * (sc + 1.0f) + sh;
                RP_ST8(ro, j, pk2(h.x, h.y), pk2(h.z, h.w)); }
        }
    }
}
template <bool XIB>
__device__ __forceinline__ void rowpass_last(const bf16* F, const void* xi, float* xo, const float* gpost, const float* mod_cur, float gmul, int gw, int NGW, int lane) {
    const int lo16 = lane * 16, lo8 = lane * 8;
    const __amdgpu_buffer_rsrc_t rgpo = mkrsrc(gpost, DM * 4);
    for (int m = gw; m < M; m += NGW) {
        const int b = m / SEQ;
        const __amdgpu_buffer_rsrc_t rf_ = mkrsrc(F + (size_t)m * DM, DM * 2), rx = mkrsrc((const char*)xi + (size_t)m * DM * (XIB ? 2 : 4), DM * (XIB ? 2 : 4)), rw = mkrsrc(xo + (size_t)m * DM, DM * 4);
        const __amdgpu_buffer_rsrc_t rga = mkrsrc(mod_cur + (size_t)b * NMOD + 2 * DM, DM * 4);
        f32x4 f[16], v[16]; float ss = 0.f;
#pragma unroll
        for (int j = 0; j < 16; ++j) { f[j] = RP_LDB4NT(rf_, j); ss += sumsq4(f[j]); }
#pragma unroll
        for (int j = 0; j < 16; ++j) { if constexpr (XIB) v[j] = RP_LDB4NT(rx, j); else v[j] = RP_LD4NT(rx, j); }
        const float rf = gmul / sqrtf(wave_sum(ss) * (1.f / DM) + EPS);
#pragma unroll
        for (int j = 0; j < 16; ++j) { const f32x4 gg = RP_LD4(rgpo, j), ga = RP_LD4(rga, j); RP_ST4NT(rw, j, v[j] + ga * (f[j] * rf * gg)); }
    }
}

__device__ __forceinline__ void pool_task(const bf16* U, const bf16* WPT, const float* pool_scale, bf16* MIX, int task, int lane) {
    const int g = task & 3, rb = task >> 2, w = 2 << g, fr = lane & 15, fq = lane >> 4, t = rb * 16 + fr, ts = t & (SEQ - 1);
    const int cnt = (ts + 1) < w ? (ts + 1) : w; const float inv = 1.f / (float)cnt;
    f32x4 acc[16];
#pragma unroll
    for (int n = 0; n < 16; ++n) acc[n] = (f32x4){0.f, 0.f, 0.f, 0.f};
    const bf16* up = U + (size_t)t * DPOOL + g * 256 + 8 * fq;
    const bf16* wp = WPT + (size_t)g * 65536 + (size_t)fr * 256 + 8 * fq;
    for (int ks = 0; ks < 8; ++ks) {
        float s[8];
#pragma unroll
        for (int i = 0; i < 8; ++i) s[i] = 0.f;
        for (int j = 0; j < w; ++j) {
            if (j < cnt) { const v4u r = *(const GAS v4u*)(up + ks * 32 - (size_t)j * DPOOL);
                s[0] += bf_lo(r.x); s[1] += bf_hi(r.x); s[2] += bf_lo(r.y); s[3] += bf_hi(r.y); s[4] += bf_lo(r.z); s[5] += bf_hi(r.z); s[6] += bf_lo(r.w); s[7] += bf_hi(r.w); }
        }
        const v4u own = *(const GAS v4u*)(up + ks * 32);
        v4u aw;
        aw.x = pk2(s[0] * inv - bf_lo(own.x), s[1] * inv - bf_hi(own.x)); aw.y = pk2(s[2] * inv - bf_lo(own.y), s[3] * inv - bf_hi(own.y));
        aw.z = pk2(s[4] * inv - bf_lo(own.z), s[5] * inv - bf_hi(own.z)); aw.w = pk2(s[6] * inv - bf_lo(own.w), s[7] * inv - bf_hi(own.w));
        const bf16x8 af = __builtin_bit_cast(bf16x8, aw);
#pragma unroll
        for (int n = 0; n < 16; ++n) { const bf16x8 bfr = *(const GAS bf16x8*)(wp + (size_t)n * 16 * 256 + ks * 32);
            acc[n] = __builtin_amdgcn_mfma_f32_16x16x32_bf16(bfr, af, acc[n], 0, 0, 0); }
    }
    bf16* op = MIX + (size_t)t * DM + g * 256 + 4 * fq; const float* psp = pool_scale + g * 256 + 4 * fq;
#pragma unroll
    for (int n = 0; n < 16; ++n) { const f32x4 ps = *(const GAS f32x4*)(psp + n * 16); const f32x4 o = acc[n] * ps;
        *(GAS unsigned long long*)(op + n * 16) = (unsigned long long)pk2(o.x, o.y) | ((unsigned long long)pk2(o.z, o.w) << 32); }
}

__device__ __forceinline__ void combine_phase(const bf16* O4, const float* subln_g, const float* lq1, const float* lk1, const float* lq2, const float* lk2, bf16* MIX, int gw, int NGW, int lane) {
    const float s1 = wave_sum(lq1[lane] * lk1[lane] + lq1[lane + 64] * lk1[lane + 64]), s2 = wave_sum(lq2[lane] * lk2[lane] + lq2[lane + 64] * lk2[lane + 64]);
    const float lam = __expf(s1) - __expf(s2) + LAMBDA_INIT;
    const int l16 = lane & 15, hq = lane >> 4, half = l16 >> 3, e0 = (l16 & 7) * 16;
    f32x4 gsub[4];
#pragma unroll
    for (int i = 0; i < 4; ++i) gsub[i] = *(const GAS f32x4*)(subln_g + half * 128 + e0 + 4 * i) * ONE_MINUS_LAMBDA_INIT;
    for (int task = gw; task < M * 3; task += NGW) {
        const int t = task / 3, h = (task % 3) * 4 + hq, b = t / SEQ, s = t % SEQ;
#if ATTN_V2
        const bf16* p1 = O4 + (((size_t)(b * NH + h) * 2 + 0) * SEQ + s) * 256 + half * 128 + e0;
        const bf16* p2 = p1 + (size_t)SEQ * 256;
#else
        const bf16* p1 = O4 + ((((size_t)(b * NH + h) * 2 + 0) * 2 + half) * SEQ + s) * 128 + e0;
        const bf16* p2 = p1 + (size_t)2 * SEQ * 128;
#endif
        const v4u a0 = __builtin_nontemporal_load((const GAS v4u*)p1), a1 = __builtin_nontemporal_load((const GAS v4u*)(p1 + 8)), c0 = __builtin_nontemporal_load((const GAS v4u*)p2), c1 = __builtin_nontemporal_load((const GAS v4u*)(p2 + 8));
        float o[16];
        o[0] = bf_lo(a0.x) - lam * bf_lo(c0.x); o[1] = bf_hi(a0.x) - lam * bf_hi(c0.x); o[2] = bf_lo(a0.y) - lam * bf_lo(c0.y); o[3] = bf_hi(a0.y) - lam * bf_hi(c0.y);
        o[4] = bf_lo(a0.z) - lam * bf_lo(c0.z); o[5] = bf_hi(a0.z) - lam * bf_hi(c0.z); o[6] = bf_lo(a0.w) - lam * bf_lo(c0.w); o[7] = bf_hi(a0.w) - lam * bf_hi(c0.w);
        o[8] = bf_lo(a1.x) - lam * bf_lo(c1.x); o[9] = bf_hi(a1.x) - lam * bf_hi(c1.x); o[10] = bf_lo(a1.y) - lam * bf_lo(c1.y); o[11] = bf_hi(a1.y) - lam * bf_hi(c1.y);
        o[12] = bf_lo(a1.z) - lam * bf_lo(c1.z); o[13] = bf_hi(a1.z) - lam * bf_hi(c1.z); o[14] = bf_lo(a1.w) - lam * bf_lo(c1.w); o[15] = bf_hi(a1.w) - lam * bf_hi(c1.w);
        float ss = 0.f;
#pragma unroll
        for (int i = 0; i < 16; ++i) ss += o[i] * o[i];
        ss += __shfl_xor(ss, 1); ss += __shfl_xor(ss, 2); ss += __shfl_xor(ss, 4); ss += __shfl_xor(ss, 8);
        const float rstd = 1.f / sqrtf(ss * (1.f / 256.f) + EPS);
        v4u w0, w1;
        w0.x = pk2(o[0] * rstd * gsub[0].x, o[1] * rstd * gsub[0].y); w0.y = pk2(o[2] * rstd * gsub[0].z, o[3] * rstd * gsub[0].w);
        w0.z = pk2(o[4] * rstd * gsub[1].x, o[5] * rstd * gsub[1].y); w0.w = pk2(o[6] * rstd * gsub[1].z, o[7] * rstd * gsub[1].w);
        w1.x = pk2(o[8] * rstd * gsub[2].x, o[9] * rstd * gsub[2].y); w1.y = pk2(o[10] * rstd * gsub[2].z, o[11] * rstd * gsub[2].w);
        w1.z = pk2(o[12] * rstd * gsub[3].x, o[13] * rstd * gsub[3].y); w1.w = pk2(o[14] * rstd * gsub[3].z, o[15] * rstd * gsub[3].w);
        bf16* op = MIX + (size_t)t * DM + DPOOL + h * 256 + half * 128 + e0;
        *(GAS v4u*)op = w0; *(GAS v4u*)(op + 8) = w1;
    }
}

__device__ __forceinline__ attn::BlockRef<attn::bf16, attn::bf16> attn_ref(const bf16* QKV, bf16* O4, int L, int pass) {
    const int x = L & 3, vh = L >> 2, half = vh & 1, map = (vh >> 1) & 1, bh = vh >> 2, b = bh / NH, h = bh % NH, qb = pass ? 7 - x : x;
    constexpr size_t SL = (size_t)SEQ * 128;
    attn::BlockRef<attn::bf16, attn::bf16> r;
    r.Q = (const attn::bf16*)QKV + ((size_t)((0 * 4 + b) * 24 + h * 2 + map)) * SL + (size_t)qb * 256 * 128;
    r.K = (const attn::bf16*)QKV + ((size_t)((1 * 4 + b) * 24 + h * 2 + map)) * SL;
    r.V = (const attn::bf16*)QKV + ((size_t)((2 * 4 + b) * 24 + h * 2 + half)) * SL;
    r.O = (attn::bf16*)O4 + ((size_t)(((b * NH + h) * 2 + map) * 2 + half)) * SL + (size_t)qb * 256 * 128;
    r.P0 = qb * 256;
    return r;
}
__device__ __forceinline__ void attn_phase(const bf16* QKV, bf16* O4, char* lds, int vcu, int G, const int tid) {
    constexpr int NITEMS = NB * NH * 2 * 2 * 4;
    const int per = (NITEMS + G - 1) / G, L0 = vcu * per, L1 = (L0 + per) < NITEMS ? (L0 + per) : NITEMS;
    if (L0 >= L1) return;
    int L = L0, pass = 0;
    attn::BlockRef<attn::bf16, attn::bf16> cur = attn_ref(QKV, O4, L, 0);
    attn::Seam<attn::bf16> S;
    attn::causal_swa_prime<attn::bf16, attn::bf16>(cur, SEQ, lds, S, tid);
    for (;;) {
        const bool more_pass = pass == 0, more_item = L + 1 < L1, last = !more_pass && !more_item;
        int passn = pass + 1, Ln = L;
        if (!more_pass) { passn = 0; Ln = more_item ? L + 1 : L; }
        const attn::BlockRef<attn::bf16, attn::bf16> nxt = last ? cur : attn_ref(QKV, O4, Ln, passn);
        attn::causal_swa_block<attn::bf16, attn::bf16>(cur, nxt, SEQ, SEQ, lds, S, tid);
        if (last) break;
        cur = nxt; pass = passn; L = Ln;
    }
}

__device__ __forceinline__ void attn_phase_v2(const bf16* QKV, bf16* O, LAS unsigned char* lds, int vcu, int G, int wave, int lane) {
    constexpr size_t SL = (size_t)SEQ * 128;
    for (int u = vcu; u < 256; u += G) {
        const int gi = u >> 3, j = u & 7;
#pragma unroll 1
        for (int k = 0; k < 3; ++k) {
            const unsigned tab = k == 0 ? 0x76543210u : (k == 1 ? 0x10576243u : 0x34102657u);
            const int qb = (int)((tab >> (4 * j)) & 15u), hh = 3 * gi + k, map = hh & 1, bh = hh >> 1, b = bh / NH, h = bh % NH;
            attx::Block B;
            B.Q = QKV + ((size_t)((0 * 4 + b) * 24 + h * 2 + map)) * SL;
            B.K = QKV + ((size_t)((1 * 4 + b) * 24 + h * 2 + map)) * SL;
            B.V0 = QKV + ((size_t)((2 * 4 + b) * 24 + h * 2 + 0)) * SL;
            B.V1 = QKV + ((size_t)((2 * 4 + b) * 24 + h * 2 + 1)) * SL;
            B.O = O + ((size_t)((b * NH + h) * 2 + map)) * SEQ * 256;
            B.qb = qb;
            int lane_ = lane; asm volatile("" : "+v"(lane_));
            attx::attn_block(B, lds, wave, lane_);
        }
    }
    asm volatile("s_waitcnt vmcnt(0)" ::: "memory"); __builtin_amdgcn_s_barrier();
}

struct Args { const float* in[21]; float* out; unsigned char* ws; int ph_lo, ph_hi; };
static_assert(sizeof(Args) == 24 * 8, "Args has no holes");
__global__ void __launch_bounds__(NWAVES * 64, 2) mk_fwd(Args args) {
    extern __shared__ __attribute__((aligned(16))) unsigned char lds[];
    LAS unsigned char* ldsl = (LAS unsigned char*)lds;
    volatile LAS unsigned* MISC = (volatile LAS unsigned*)(ldsl + MISC_OFF);
    const int wave = __builtin_amdgcn_readfirstlane(threadIdx.x >> 6);
#define MK_LANE() ({ int l_; asm volatile("v_mbcnt_lo_u32_b32 %0, -1, 0\n\tv_mbcnt_hi_u32_b32 %0, -1, %0" : "=v"(l_)); l_; })
    const int G = gridDim.x, bx = blockIdx.x, vcu = (G % 8 == 0) ? (bx % 8) * (G / 8) + bx / 8 : bx;
    const int gw = vcu * NWAVES + wave, NGW = G * NWAVES;
    unsigned char* ws = args.ws;
    gu32* ctl = (gu32*)(ws + WS_CTL);
    const float *x = args.in[0], *c = args.in[1], *w_ada = args.in[2], *b_ada = args.in[3], *pre_g = args.in[4], *post_g = args.in[5];
    const float *pool_scale = args.in[11], *lq1 = args.in[12], *lk1 = args.in[13], *lq2 = args.in[14], *lk2 = args.in[15], *subln_g = args.in[16];
    float* out = args.out;
    float* mod = (float*)(ws + WS_MOD);
    bf16 *WPT = (bf16*)(ws + WS_WPT), *W13A = (bf16*)(ws + WS_W13A), *W2A = (bf16*)(ws + WS_W2A), *W13B = (bf16*)(ws + WS_W13B), *W2B = (bf16*)(ws + WS_W2B), *WIN = (bf16*)(ws + WS_WIN), *WOUT = (bf16*)(ws + WS_WOUT);
    bf16 *XN = (bf16*)(ws + WS_XN), *ACT = (bf16*)(ws + WS_ACT), *U = (bf16*)(ws + WS_U), *QKV = (bf16*)(ws + WS_QKV), *O4 = (bf16*)(ws + WS_O4), *MIX = (bf16*)(ws + WS_MIX);
    bf16* F = (bf16*)(ws + WS_F);
    bf16* XR = (bf16*)(ws + WS_XR);

    { const int tid0 = wave * 64 + MK_LANE();
      for (int u = tid0; u < (LDS_BYTES - LDSCTL_OFF) / 4; u += NWAVES * 64) ((LAS unsigned*)(ldsl + LDSCTL_OFF))[u] = 0u; }
    __syncthreads();
    XcdBarrier bar; bar.bar = (unsigned*)(ctl + CW_BAR); bar.x = 0; bar.st = nullptr;
    if (N_LAUNCHES == 1) bar = xcd_barrier_post((unsigned*)(ctl + CW_BAR), MISC + 8);
#define GRID_BAR() do { if (N_LAUNCHES == 1) xcd_barrier(bar, wave * 64 + MK_LANE()); } while (0)
    const int lo = args.ph_lo, hi = args.ph_hi;
#define IN(k) (lo <= (k) && (k) < hi)
#ifndef PROBE_DUP
#define PROBE_DUP -1
#endif
#define REP(k) for (int rep_ = 0; rep_ < ((PROBE_DUP == (k)) ? 2 : 1); ++rep_)
#define BOTH(k) (IN(k) && IN((k) + 1))

    gu32* AM = ctl + CW_AMAX;
    float* RS = (float*)(ws + WS_RS);
    if (IN(0)) REP(0) {
        const int lane = MK_LANE(), tid = wave * 64 + lane;
        p0_adaln(c, w_ada, b_ada, mod, ldsl, vcu, G, tid);
        WPtrs P{args.in[6], args.in[7], args.in[8], args.in[18], args.in[19], args.in[20], args.in[9], args.in[17], args.in[10], W13A, W2A, W13B, W2B, WIN, WOUT, WPT};
#if FFN_UP_INT8
        p0_convert(P, ldsl, gw, NGW, wave, lane, 2, 6);
#else
        p0_convert(P, ldsl, gw, NGW, wave, lane, 0, CV_SPLIT ? 6 : 10);
#endif
        if (BOTH(0)) GRID_BAR();
    }
    if (IN(1)) REP(1) {
#if FFN_UP_INT8
        rowpass_first<true>(x, pre_g, mod, XN, RS, gw, NGW, MK_LANE());
        w13_strips_i8(args.in[6], args.in[7], (unsigned char*)W13A, (float*)(unsigned*)AM, (float*)(unsigned*)(AM + DFF), ldsl, vcu, G, wave, MK_LANE());
        w2_convert(args.in[8], W2A, ldsl, vcu, G, wave, MK_LANE(), W2_SPLIT, W2_ITEMS);
#else
        rowpass_first<false>(x, pre_g, mod, XN, RS, gw, NGW, MK_LANE());
#endif
        if (BOTH(1)) GRID_BAR(); }
    if (IN(2)) REP(2) {
        pg8::Gemm g{XN, W13A, M, 2 * DFF, DM}; pg8::StaticOrder S; S.init(M, 2 * DFF, G, bx);
#if FFN_UP_INT8
        pg8::EpiSwiGLUi8 E{ACT, DFF, RS, (const float*)(unsigned*)AM, (const float*)(unsigned*)(AM + DFF)};
        pg8::gemm_phase<pg8::EpiSwiGLUi8, pg8::StaticOrder, true, true, 2>(ldsl + RING_OFF, g, S, E, wave * 64 + MK_LANE());
#else
        pg8::EpiSwiGLU E{ACT, DFF};
        pg8::gemm_phase<pg8::EpiSwiGLU, pg8::StaticOrder, true, true>(ldsl + RING_OFF, g, S, E, wave * 64 + MK_LANE());
#endif
        { const int rem = S.nwg % G, nconv = rem ? G - rem : G, rank = rem ? bx - rem : bx;
          if (rank >= 0) w2_convert(args.in[8], W2A, ldsl, rank, nconv, wave, MK_LANE(), 0, W2_SPLIT); }
        if (BOTH(2)) GRID_BAR();
    }
#ifdef PROBE_IDLE_US
    if (IN(3)) { const unsigned long long t0_ = __builtin_amdgcn_s_memrealtime(); while (__builtin_amdgcn_s_memrealtime() - t0_ < (unsigned long long)PROBE_IDLE_US * 100ull) __builtin_amdgcn_s_sleep(32); }
#endif
    if (IN(3)) REP(3) {
        pg8::Gemm g{ACT, W2A, M, DM, DFF}; pg8::StaticOrder S; S.init(M, DM, G, bx);
        pg8::EpiBf16P E{F, DM};
        pg8::gemm_phase<pg8::EpiBf16P, pg8::StaticOrder, true, true, 0, DOWN_AUXA, DOWN_AUXB>(ldsl + RING_OFF, g, S, E, wave * 64 + MK_LANE());
        if (BOTH(3)) GRID_BAR();
    }
    if (IN(4)) REP(4) { rowpass_mid<false, false, true>(F, x, XR, XN, RS, post_g, pre_g + DM, mod, mod + 3 * DM, 0.5f, gw, NGW, MK_LANE());
        if (CV_SPLIT) { WPtrs P{args.in[6], args.in[7], args.in[8], args.in[18], args.in[19], args.in[20], args.in[9], args.in[17], args.in[10], W13A, W2A, W13B, W2B, WIN, WOUT, WPT};
            p0_convert(P, ldsl, gw, NGW, wave, MK_LANE(), 6, 8); }
        if (BOTH(4)) GRID_BAR(); }
    if (IN(5)) REP(5) {
        pg8::Gemm g{XN, WIN, M, DIN, DM}; pg8::StaticOrder S; S.init(M, DIN, G, bx);
        pg8::EpiProj E{U, QKV};
        pg8::gemm_phase<pg8::EpiProj, pg8::StaticOrder, true, true>(ldsl + RING_OFF, g, S, E, wave * 64 + MK_LANE());
        if (BOTH(5)) GRID_BAR();
    }
    if (IN(6)) REP(6) {
        { const int lane = MK_LANE(); for (int task = gw; task < (M / 16) * 4; task += NGW) pool_task(U, WPT, pool_scale, MIX, task, lane); }
#if ATTN_V2
        attn_phase_v2(QKV, O4, ldsl + RING_OFF, vcu, G, wave, MK_LANE());
#else
        attn_phase(QKV, O4, (char*)lds + RING_OFF, vcu, G, wave * 64 + MK_LANE());
#endif
        if (BOTH(6)) GRID_BAR();
    }
    if (IN(7)) REP(7) { combine_phase(O4, subln_g, lq1, lk1, lq2, lk2, MIX, gw, NGW, MK_LANE()); if (BOTH(7)) GRID_BAR(); }
    if (IN(8)) REP(8) {
        pg8::Gemm g{MIX, WOUT, M, DM, DM}; pg8::StaticOrder S; S.init(M, DM, G, bx);
        pg8::EpiBf16P E{F, DM};
        pg8::gemm_phase<pg8::EpiBf16P, pg8::StaticOrder, true, true>(ldsl + RING_OFF, g, S, E, wave * 64 + MK_LANE());
        if (BOTH(8)) GRID_BAR();
    }
    if (IN(9)) REP(9) {
#if FFN_UP_INT8
        rowpass_mid<true, true, true>(F, XR, XR, XN, RS, post_g + DM, pre_g + 2 * DM, mod + 3 * DM, mod + 6 * DM, 1.0f, gw, NGW, MK_LANE());
        w13_strips_i8(args.in[18], args.in[19], (unsigned char*)W13B, (float*)(unsigned*)(AM + 2 * DFF), (float*)(unsigned*)(AM + 3 * DFF), ldsl, vcu, G, wave, MK_LANE());
        w2_convert(args.in[20], W2B, ldsl, vcu, G, wave, MK_LANE(), W2_SPLIT, W2_ITEMS);
#else
        rowpass_mid<false, true, true>(F, XR, XR, XN, RS, post_g + DM, pre_g + 2 * DM, mod + 3 * DM, mod + 6 * DM, 1.0f, gw, NGW, MK_LANE());
        if (CV_SPLIT) { WPtrs P{args.in[6], args.in[7], args.in[8], args.in[18], args.in[19], args.in[20], args.in[9], args.in[17], args.in[10], W13A, W2A, W13B, W2B, WIN, WOUT, WPT};
            p0_convert(P, ldsl, gw, NGW, wave, MK_LANE(), 8, 10); }
#endif
        if (BOTH(9)) GRID_BAR(); }
    if (IN(10)) REP(10) {
        pg8::Gemm g{XN, W13B, M, 2 * DFF, DM}; pg8::StaticOrder S; S.init(M, 2 * DFF, G, bx);
#if FFN_UP_INT8
        pg8::EpiSwiGLUi8 E{ACT, DFF, RS, (const float*)(unsigned*)(AM + 2 * DFF), (const float*)(unsigned*)(AM + 3 * DFF)};
        pg8::gemm_phase<pg8::EpiSwiGLUi8, pg8::StaticOrder, true, true, 2>(ldsl + RING_OFF, g, S, E, wave * 64 + MK_LANE());
#elif FFN2_DOWN_FP8
        pg8::EpiSwiGLU8 E{(unsigned char*)ACT, DFF, F8_SA};
        pg8::gemm_phase<pg8::EpiSwiGLU8, pg8::StaticOrder, true, true>(ldsl + RING_OFF, g, S, E, wave * 64 + MK_LANE());
#else
        pg8::EpiSwiGLU E{ACT, DFF};
        pg8::gemm_phase<pg8::EpiSwiGLU, pg8::StaticOrder, true, true>(ldsl + RING_OFF, g, S, E, wave * 64 + MK_LANE());
#endif
        { const int rem = S.nwg % G, nconv = rem ? G - rem : G, rank = rem ? bx - rem : bx;
#if FFN2_DOWN_FP8
          if (rank >= 0) w2_convert8(args.in[20], (unsigned char*)W2B, F8_SW, ldsl, rank, nconv, wave, MK_LANE()); }
#else
          if (rank >= 0) w2_convert(args.in[20], W2B, ldsl, rank, nconv, wave, MK_LANE(), 0, W2_SPLIT); }
#endif
        if (BOTH(10)) GRID_BAR();
    }
    if (IN(11)) REP(11) {
#if FFN2_DOWN_FP8
        pg8::Gemm g{ACT, W2B, M, DM, DFF}; pg8::StaticOrder S; S.init(M, DM, G, bx);
        pg8::EpiBf16S E{F, DM, 1.0f / (F8_SA * F8_SW)};
        pg8::gemm_phase<pg8::EpiBf16S, pg8::StaticOrder, true, true, 1>(ldsl + RING_OFF, g, S, E, wave * 64 + MK_LANE());
#else
        pg8::Gemm g{ACT, W2B, M, DM, DFF}; pg8::StaticOrder S; S.init(M, DM, G, bx);
        pg8::EpiBf16P E{F, DM};
        pg8::gemm_phase<pg8::EpiBf16P, pg8::StaticOrder, true, true, 0, DOWN_AUXA, DOWN_AUXB>(ldsl + RING_OFF, g, S, E, wave * 64 + MK_LANE());
#endif
        if (BOTH(11)) GRID_BAR();
    }
    if (IN(12)) REP(12) { rowpass_last<true>(F, XR, out, post_g + 2 * DM, mod + 6 * DM, 0.5f, gw, NGW, MK_LANE()); }
#undef IN
#undef BOTH
#undef GRID_BAR
}

extern "C" void kernel_launch(void* const* d_in, const int* in_sizes, int n_in, void* d_out, int out_size, void* d_ws, size_t ws_size, hipStream_t stream) {
    static int grid = 0;
    if (grid == 0) {
        if (n_in != 21 || in_sizes[0] != M * DM || out_size != M * DM || ws_size < WS_END) { fprintf(stderr, "kernel_launch: unexpected shapes (n_in %d, in0 %d, out %d, ws %zu); nothing launched\n", n_in, n_in > 0 ? in_sizes[0] : -1, out_size, ws_size); grid = -1; return; }
        int dev = 0, cus = 0, per_cu = 0;
        if (hipGetDevice(&dev) != hipSuccess || hipDeviceGetAttribute(&cus, hipDeviceAttributeMultiprocessorCount, dev) != hipSuccess) { fprintf(stderr, "kernel_launch: device query failed\n"); grid = -1; return; }
        if (hipFuncSetAttribute((const void*)mk_fwd, hipFuncAttributeMaxDynamicSharedMemorySize, LDS_BYTES) != hipSuccess) { fprintf(stderr, "kernel_launch: hipFuncSetAttribute failed\n"); grid = -1; return; }
        if (hipOccupancyMaxActiveBlocksPerMultiprocessor(&per_cu, (const void*)mk_fwd, NWAVES * 64, LDS_BYTES) != hipSuccess || per_cu < 1) fprintf(stderr, "kernel_launch: note: occupancy query reports %d workgroups per CU\n", per_cu);
        (void)hipGetLastError();
        grid = cus;
    }
    if (grid < 0) return;
    if (hipMemsetAsync((char*)d_ws + WS_CTL, 0, CTL_ZERO_BYTES, stream) != hipSuccess) { fprintf(stderr, "kernel_launch: hipMemsetAsync failed\n"); return; }
    Args a{};
    for (int i = 0; i < 21; ++i) a.in[i] = (const float*)d_in[i];
    a.out = (float*)d_out; a.ws = (unsigned char*)d_ws;
    for (int li = 0; li < N_LAUNCHES; ++li) {
        a.ph_lo = (N_LAUNCHES == 1) ? 0 : li; a.ph_hi = (N_LAUNCHES == 1) ? N_PHASES : li + 1;
        hipLaunchKernelGGL(mk_fwd, dim3(grid), dim3(NWAVES * 64), LDS_BYTES, stream, a);
        const hipError_t le = hipPeekAtLastError();
        if (le != hipSuccess) { fprintf(stderr, "kernel_launch: launch %d failed: %s\n", li, hipGetErrorName(le)); break; }
    }
}
```
